# Optimizing an MI355X kernel written in HIP

```python
import math
import jax, jax.numpy as jnp
from jax import lax
import numpy as np

D_MODEL = 2048
BATCH = 16
SEQ = 2048
DEPTH = 4

N_META = 16
ATTN_WIDTH = 1024
POOL_WIDTH = D_MODEL - ATTN_WIDTH
DIFF_HEAD_DIM = 64
DIFF_V_DIM = 2 * DIFF_HEAD_DIM
N_DIFF_HEADS = ATTN_WIDTH // DIFF_V_DIM
POOL_WINDOWS = (2, 4, 8, 16)
N_POOL_GROUPS = len(POOL_WINDOWS)
POOL_GROUP_WIDTH = POOL_WIDTH // N_POOL_GROUPS
IN_WIDTH = 3 * ATTN_WIDTH + POOL_WIDTH
D_FF = 5632
ROPE_THETA = 10000.0
Q_BLOCK = 128
NORM_EPS = 1e-6
SUBLN_EPS = 1e-5

kernel_name = "hymba_diffattn_pool_macaron"


def rms_norm(x, g, eps):
    xf = x.astype(jnp.float32)
    y = xf * lax.rsqrt(jnp.mean(xf * xf, axis=-1, keepdims=True) + eps)
    return (y * g.astype(jnp.float32)).astype(x.dtype)


def swiglu(h, w_gate, w_up, w_down):
    return (jax.nn.silu(h @ w_gate) * (h @ w_up)) @ w_down


def rope_tables(length):
    pos = jnp.arange(length, dtype=jnp.float32)
    inv_freq = 1.0 / (ROPE_THETA ** (jnp.arange(0, DIFF_HEAD_DIM, 2, dtype=jnp.float32) / DIFF_HEAD_DIM))
    ang = pos[:, None] * inv_freq[None, :]
    ang = jnp.concatenate([ang, ang], axis=-1)
    return jnp.cos(ang), jnp.sin(ang)


def apply_rope(x, cos, sin):
    xf = x.astype(jnp.float32)
    half = DIFF_HEAD_DIM // 2
    rot = jnp.concatenate([-xf[..., half:], xf[..., :half]], axis=-1)
    c = cos[None, :, None, None, :]
    s = sin[None, :, None, None, :]
    return (xf * c + rot * s).astype(x.dtype)


def diff_attention(q, k, v, lam):
    length = q.shape[1]
    outs = []
    for i in range(length // Q_BLOCK):
        start, end = i * Q_BLOCK, (i + 1) * Q_BLOCK
        qb, kb, vb = q[:, start:end], k[:, :end], v[:, :end]
        s = jnp.einsum('bqhmd,bkhmd->bhmqk', qb, kb).astype(jnp.float32)
        qpos = start + jnp.arange(Q_BLOCK)
        kpos = jnp.arange(end)
        mask = kpos[None, :] <= qpos[:, None]
        s = jnp.where(mask, s, jnp.finfo(jnp.float32).min)
        p = jax.nn.softmax(s, axis=-1)
        a = p[:, :, 0] - lam * p[:, :, 1]
        outs.append(jnp.einsum('bhqk,bkhe->bqhe', a.astype(v.dtype), vb))
    return jnp.concatenate(outs, axis=1)


def causal_multiscale_pool(u, w_pool, pool_scale):
    b, length, _ = u.shape
    uf = u.reshape(b, length, N_POOL_GROUPS, POOL_GROUP_WIDTH).astype(jnp.float32)
    cs = jnp.cumsum(uf, axis=1)
    t = jnp.arange(length)
    means = []
    for g, w in enumerate(POOL_WINDOWS):
        c = cs[:, :, g]
        lagged = jnp.pad(c, ((0, 0), (w, 0), (0, 0)))[:, :length]
        count = jnp.minimum(t + 1, w).astype(jnp.float32)[None, :, None]
        means.append((c - lagged) / count)
    diff = (jnp.stack(means, axis=2) - uf).astype(u.dtype)
    y = jnp.einsum('blgc,gcd->blgd', diff, w_pool).reshape(b, length, POOL_WIDTH)
    return y * pool_scale


def hybrid_mixer(h, w_in, lam_q1, lam_k1, lam_q2, lam_k2, subln_g, w_pool, pool_scale, w_out, cos, sin, lam_init):
    b, length, _ = h.shape
    proj = h @ w_in
    q, k, v, u = jnp.split(proj, [ATTN_WIDTH, 2 * ATTN_WIDTH, 3 * ATTN_WIDTH], axis=-1)
    q = apply_rope(q.reshape(b, length, N_DIFF_HEADS, 2, DIFF_HEAD_DIM), cos, sin) * (DIFF_HEAD_DIM ** -0.5)
    k = apply_rope(k.reshape(b, length, N_DIFF_HEADS, 2, DIFF_HEAD_DIM), cos, sin)
    v = v.reshape(b, length, N_DIFF_HEADS, DIFF_V_DIM)
    lam = (jnp.exp(jnp.sum(lam_q1.astype(jnp.float32) * lam_k1.astype(jnp.float32)))
           - jnp.exp(jnp.sum(lam_q2.astype(jnp.float32) * lam_k2.astype(jnp.float32)))
           + lam_init)
    o = diff_attention(q, k, v, lam)
    o = rms_norm(o, subln_g, SUBLN_EPS) * (1.0 - lam_init)
    attn_out = o.reshape(b, length, ATTN_WIDTH)
    pool_out = causal_multiscale_pool(u, w_pool, pool_scale)
    return jnp.concatenate([attn_out, pool_out], axis=-1) @ w_out


def setup_inputs(seed: int = 0) -> dict:
    key = jax.random.key(seed)
    ks = jax.random.split(key, 24)
    f32 = jnp.float32
    nrm = lambda k, shape, s: jax.random.normal(k, shape, f32) * s
    gain = lambda k, shape: 1.0 + 0.02 * jax.random.normal(k, shape, f32)
    return {
        "x": nrm(ks[0], (BATCH, SEQ, D_MODEL), 1.0),
        "meta_tokens": nrm(ks[1], (N_META, D_MODEL), 1.0),
        "ffn1_norm_g": gain(ks[2], (DEPTH, D_MODEL)),
        "ffn1_w_gate": nrm(ks[3], (DEPTH, D_MODEL, D_FF), D_MODEL ** -0.5),
        "ffn1_w_up": nrm(ks[4], (DEPTH, D_MODEL, D_FF), D_MODEL ** -0.5),
        "ffn1_w_down": nrm(ks[5], (DEPTH, D_FF, D_MODEL), D_FF ** -0.5),
        "mix_norm_g": gain(ks[6], (DEPTH, D_MODEL)),
        "w_in": nrm(ks[7], (DEPTH, D_MODEL, IN_WIDTH), D_MODEL ** -0.5),
        "lam_q1": nrm(ks[8], (DEPTH, DIFF_HEAD_DIM), 0.1),
        "lam_k1": nrm(ks[9], (DEPTH, DIFF_HEAD_DIM), 0.1),
        "lam_q2": nrm(ks[10], (DEPTH, DIFF_HEAD_DIM), 0.1),
        "lam_k2": nrm(ks[11], (DEPTH, DIFF_HEAD_DIM), 0.1),
        "subln_g": gain(ks[12], (DEPTH, DIFF_V_DIM)),
        "w_pool": nrm(ks[13], (DEPTH, N_POOL_GROUPS, POOL_GROUP_WIDTH, POOL_GROUP_WIDTH), POOL_GROUP_WIDTH ** -0.5),
        "pool_scale": gain(ks[14], (DEPTH, POOL_WIDTH)),
        "w_out": nrm(ks[15], (DEPTH, D_MODEL, D_MODEL), D_MODEL ** -0.5),
        "ffn2_norm_g": gain(ks[16], (DEPTH, D_MODEL)),
        "ffn2_w_gate": nrm(ks[17], (DEPTH, D_MODEL, D_FF), D_MODEL ** -0.5),
        "ffn2_w_up": nrm(ks[18], (DEPTH, D_MODEL, D_FF), D_MODEL ** -0.5),
        "ffn2_w_down": nrm(ks[19], (DEPTH, D_FF, D_MODEL), D_FF ** -0.5),
        "final_norm_g": gain(ks[20], (D_MODEL,)),
    }


def reference(x, meta_tokens, ffn1_norm_g, ffn1_w_gate, ffn1_w_up, ffn1_w_down, mix_norm_g, w_in,
              lam_q1, lam_k1, lam_q2, lam_k2, subln_g, w_pool, pool_scale, w_out,
              ffn2_norm_g, ffn2_w_gate, ffn2_w_up, ffn2_w_down, final_norm_g):
    b, seq, d = x.shape
    total = N_META + seq
    pad = (-total) % Q_BLOCK
    meta = jnp.broadcast_to(meta_tokens.astype(x.dtype)[None], (b, N_META, d))
    h = jnp.concatenate([meta, x, jnp.zeros((b, pad, d), x.dtype)], axis=1)
    cos, sin = rope_tables(h.shape[1])
    for layer in range(DEPTH):
        lam_init = 0.8 - 0.6 * math.exp(-0.3 * layer)
        h = h + 0.5 * swiglu(rms_norm(h, ffn1_norm_g[layer], NORM_EPS),
                             ffn1_w_gate[layer], ffn1_w_up[layer], ffn1_w_down[layer])
        h = h + hybrid_mixer(rms_norm(h, mix_norm_g[layer], NORM_EPS), w_in[layer],
                             lam_q1[layer], lam_k1[layer], lam_q2[layer], lam_k2[layer], subln_g[layer],
                             w_pool[layer], pool_scale[layer], w_out[layer], cos, sin, lam_init)
        h = h + 0.5 * swiglu(rms_norm(h, ffn2_norm_g[layer], NORM_EPS),
                             ffn2_w_gate[layer], ffn2_w_up[layer], ffn2_w_down[layer])
    h = rms_norm(h, final_norm_g, NORM_EPS)
    return h[:, N_META:N_META + seq]
```

```cpp
#include <hip/hip_runtime.h>
#include <hip/hip_bf16.h>
#include <cstdio>
#include <cstdint>
#include <cmath>

constexpr int D_ = 2048, NBATCH = 16, NSEQ = 2048, DEPTH = 4, NMETA = 16, FF_ = 5632, INW = 4096, NHEADS = 8;
constexpr int MREAL = NBATCH * NSEQ;
constexpr int MROWS = MREAL + 256;
constexpr int VSEQ = 2112;
constexpr int VROWS = NBATCH * VSEQ;
constexpr int NPOS = NMETA + NSEQ;
constexpr float NORM_EPS = 1e-6f, SUBLN_EPS = 1e-5f;
constexpr float QSCALE = 0.125f * 1.4426950408889634f;

namespace pg8 {
#define PG8_LAS __attribute__((address_space(3)))
typedef unsigned short bf16_t;
typedef short bf16x8 __attribute__((ext_vector_type(8)));
typedef float f32x4 __attribute__((ext_vector_type(4)));
typedef unsigned u32x4 __attribute__((ext_vector_type(4)));
constexpr int BM = 256, BK = 64, HALF = 128, HTB = HALF * BK * 2  , STAGE_BYTES = 8 * HTB, NXCD = 8, WGM = 8;

__host__ __device__ __forceinline__ int lds_byte(int r, int c) { const int st = (r >> 4) * 2 + (c >> 5), rr = r & 15, cc = c & 31, ob = rr * 64 + cc * 2; return st * 1024 + (ob ^ (((ob >> 9) & 1) << 5)); }
__host__ __device__ __forceinline__ void stage_rc(int b, int& R, int& C) { const int st = b / 1024, sb = b % 1024, swz = sb ^ (((sb >> 9) & 1) << 5); R = (st >> 1) * 16 + swz / 64; C = (st & 1) * 32 + (swz % 64) / 2; }
__host__ __device__ __forceinline__ int perm32(int rho) { const int n = rho >> 4, i = rho & 15; return 8 * (i >> 2) + 4 * n + (i & 3); }

struct Unit { int pm, pn; };
struct Gemm { const bf16_t* A; const bf16_t* Bt; int M, N, K; };

struct StaticOrder {
    int nM, nN, nwg, G, c;
    __host__ __device__ void init(int M, int N, int G_, int c_) { nM = M / BM; nN = N / BM; nwg = nM * nN; G = G_; c = c_; }
    __host__ __device__ bool next(int i, Unit& u) const {
        const long L = (long)i * G + c; if (L >= nwg) return false;
        int wgid = (int)L; { const int q = nwg / NXCD, r = nwg % NXCD, xcd = wgid % NXCD, off = wgid / NXCD; wgid = (xcd < r ? xcd * (q + 1) : r * (q + 1) + (xcd - r) * q) + off; }
        const int nig = WGM * nN, gid = wgid / nig, fm = gid * WGM, gsz = (nM - fm) < WGM ? (nM - fm) : WGM;
        u.pm = fm + ((wgid % nig) % gsz); u.pn = (wgid % nig) / gsz; return true;
    }
    __device__ __forceinline__ void a_ready(const Unit&) const {}
    __device__ __forceinline__ void done(const Unit&) const {}
};

__device__ __forceinline__ unsigned cvt_pk_bf16(float lo, float hi) { unsigned r; asm volatile("v_cvt_pk_bf16_f32 %0, %1, %2" : "=v"(r) : "v"(lo), "v"(hi)); return r; }
typedef float f32x2 __attribute__((ext_vector_type(2)));
__device__ __forceinline__ float row_rstd(const float* ssq, int row) {
    float s = 0.f;
#pragma unroll
    for (int p = 0; p < 8; ++p) s += ssq[(size_t)p * MROWS + row];
    return 1.0f / sqrtf(s * (1.0f / 2048.0f) + NORM_EPS);
}
struct EpiSwiGLU {
    static constexpr bool PERM = true, AFTER_DRAIN = false;
    bf16_t* O; const float* ssq;
    __device__ __forceinline__ void operator()(const f32x4 (&acc)[2][2][4][2], const Unit& u, int wr, int wc, int fr, int fq) const {
        const int row0 = u.pm * BM + wr * 64 + fr, col0 = u.pn * HALF + wc * 32 + 8 * fq;
        float rs[2][4];
#pragma unroll
        for (int ai = 0; ai < 2; ++ai)
#pragma unroll
            for (int m = 0; m < 4; ++m) rs[ai][m] = row_rstd(ssq, row0 + ai * HALF + m * 16);
#pragma unroll
        for (int ai = 0; ai < 2; ++ai)
#pragma unroll
            for (int m = 0; m < 4; ++m) { const float r = rs[ai][m]; float o[8];
#pragma unroll
                for (int n = 0; n < 2; ++n)
#pragma unroll
                    for (int i = 0; i < 4; ++i) { const float g = acc[ai][0][m][n][i] * r, up = acc[ai][1][m][n][i] * r;
                        const float e = __builtin_amdgcn_exp2f(g * -1.4426950408889634f); o[4 * n + i] = g * up * __builtin_amdgcn_rcpf(1.0f + e); }
                u32x4 w; w.x = cvt_pk_bf16(o[0], o[1]); w.y = cvt_pk_bf16(o[2], o[3]); w.z = cvt_pk_bf16(o[4], o[5]); w.w = cvt_pk_bf16(o[6], o[7]);
                *(u32x4*)(O + (size_t)(row0 + ai * HALF + m * 16) * FF_ + col0) = w; }
    }
};
struct EpiResid {
    static constexpr bool PERM = true, AFTER_DRAIN = false;
    float* H; bf16_t* HB; float* ssq_out; float scale; PG8_LAS unsigned char* xr;
    __device__ __forceinline__ void operator()(const f32x4 (&acc)[2][2][4][2], const Unit& u, int wr, int wc, int fr, int fq) const {
        const int row0 = u.pm * BM + wr * 64 + fr, col0 = u.pn * BM + wc * 32 + 8 * fq;
        PG8_LAS float* XS = (PG8_LAS float*)xr + (wr * 4 + wc) * 128;
#pragma unroll
        for (int ai = 0; ai < 2; ++ai)
#pragma unroll
            for (int m = 0; m < 4; ++m) { const size_t off = (size_t)(row0 + ai * HALF + m * 16) * D_ + col0; float s = 0.f;
#pragma unroll
                for (int bj = 0; bj < 2; ++bj) { float* hp = H + off + bj * HALF;
                    f32x4 h0 = *(const f32x4*)hp, h1 = *(const f32x4*)(hp + 4);
                    h0 = h0 + acc[ai][bj][m][0] * scale; h1 = h1 + acc[ai][bj][m][1] * scale;
                    *(f32x4*)hp = h0; *(f32x4*)(hp + 4) = h1;
                    u32x4 w; w.x = cvt_pk_bf16(h0[0], h0[1]); w.y = cvt_pk_bf16(h0[2], h0[3]); w.z = cvt_pk_bf16(h1[0], h1[1]); w.w = cvt_pk_bf16(h1[2], h1[3]);
                    *(u32x4*)(HB + off + bj * HALF) = w;
                    s += (h0[0] * h0[0] + h0[1] * h0[1]) + (h0[2] * h0[2] + h0[3] * h0[3]) + (h1[0] * h1[0] + h1[1] * h1[1]) + (h1[2] * h1[2] + h1[3] * h1[3]); }
                s += __shfl_xor(s, 16); s += __shfl_xor(s, 32);
                if (fq == 0) XS[ai * 64 + m * 16 + fr] = s;
                if (m & 1) asm volatile("" ::: "memory"); }
        asm volatile("s_waitcnt lgkmcnt(0)" ::: "memory");
        PG8_LAS unsigned* cnt = (PG8_LAS unsigned*)(xr + 4096) + wr;
        unsigned old = 0u; const int lane = fq * 16 + fr;
        if (lane == 0) old = __hip_atomic_fetch_add(cnt, 1u, __ATOMIC_RELAXED, __HIP_MEMORY_SCOPE_WORKGROUP);
        old = (unsigned)__builtin_amdgcn_readfirstlane((int)old);
        asm volatile("" ::: "memory");
        if ((old & 3u) == 3u) {
            const PG8_LAS float* X0 = (const PG8_LAS float*)xr + (wr * 4) * 128;
#pragma unroll
            for (int k = 0; k < 2; ++k) { const int q = lane + 64 * k; const float t = ((X0[q] + X0[128 + q]) + X0[256 + q]) + X0[384 + q];
                ssq_out[(size_t)u.pn * MROWS + u.pm * BM + 128 * k + 64 * wr + lane] = t; }
            asm volatile("s_waitcnt lgkmcnt(0)" ::: "memory");
        }
    }
};
struct EpiProj {
    static constexpr bool PERM = true, AFTER_DRAIN = false;
    bf16_t* P; const float* ssq; const float* rcos; const float* rsin;
    __device__ __forceinline__ void operator()(const f32x4 (&acc)[2][2][4][2], const Unit& u, int wr, int wc, int fr, int fq) const {
        const int rt0 = wr * 64 + fr, pn = u.pn;
#pragma unroll
        for (int ai = 0; ai < 2; ++ai)
#pragma unroll
            for (int m = 0; m < 4; ++m) { const int rt = rt0 + ai * HALF + m * 16; float r = row_rstd(ssq, u.pm * BM + rt);
                int vrow, pos;
                if (u.pm < MREAL / BM) { const int b = u.pm >> 3, t = (u.pm & 7) * BM + rt; vrow = b * VSEQ + 64 + t; pos = NMETA + t; }
                else { const int b = rt >> 4, j = rt & 15; vrow = b * VSEQ + 48 + j; pos = j; }
                bf16_t* op = P + (size_t)vrow * INW + pn * BM;
                if (pn < 8) {
                    if (pn < 4) r *= QSCALE;
                    const int f0 = 16 * (wc & 1) + 4 * fq;
                    const f32x4 c = *(const f32x4*)(rcos + pos * 32 + f0), s = *(const f32x4*)(rsin + pos * 32 + f0);
#pragma unroll
                    for (int bj = 0; bj < 2; ++bj) { const f32x4 xl = acc[ai][bj][m][0] * r, xh = acc[ai][bj][m][1] * r;
                        const f32x4 ol = xl * c - xh * s, oh = xh * c + xl * s;
                        typedef unsigned u32x2v __attribute__((ext_vector_type(2)));
                        u32x2v wl, wh; wl.x = cvt_pk_bf16(ol[0], ol[1]); wl.y = cvt_pk_bf16(ol[2], ol[3]); wh.x = cvt_pk_bf16(oh[0], oh[1]); wh.y = cvt_pk_bf16(oh[2], oh[3]);
                        bf16_t* hp = op + 64 * (2 * bj + (wc >> 1)) + f0;
                        *(u32x2v*)hp = wl; *(u32x2v*)(hp + 32) = wh; }
                } else {
#pragma unroll
                    for (int bj = 0; bj < 2; ++bj) { const f32x4 v0 = acc[ai][bj][m][0] * r, v1 = acc[ai][bj][m][1] * r;
                        u32x4 w; w.x = cvt_pk_bf16(v0[0], v0[1]); w.y = cvt_pk_bf16(v0[2], v0[3]); w.z = cvt_pk_bf16(v1[0], v1[1]); w.w = cvt_pk_bf16(v1[2], v1[3]);
                        *(u32x4*)(op + bj * HALF + wc * 32 + 8 * fq) = w; }
                }
                asm volatile("" ::: "memory");
            }
    }
};

template <class Epi, class Sched, bool ALIGN_EPI = false, bool SP2 = false>
__device__ __forceinline__ void gemm_phase(PG8_LAS unsigned char* lds, const Gemm g, const Sched& S, const Epi& E) {
    int tid_ = threadIdx.x; asm volatile("" : "+v"(tid_));
    const int tid = tid_, wid = __builtin_amdgcn_readfirstlane(tid >> 6), lane = tid & 63, wr = wid >> 2, wc = wid & 3, fr = lane & 15, fq = lane >> 4;
    const int K = g.K, nt = K / BK;
    unsigned voffA[2], voffB[2];
#pragma unroll
    for (int i = 0; i < 2; ++i) { int R, C; stage_rc(tid * 16 + i * 8192, R, C); const int Rb = Epi::PERM ? ((R & ~31) + perm32(R & 31)) : R;
        voffA[i] = (unsigned)(R * K + C) * 2u; voffB[i] = (unsigned)(Rb * K + C) * 2u; }
    const size_t kstep = (size_t)(BK * 2);
    const size_t hstep = (size_t)HALF * K * 2;
    const size_t tstep = 2 * hstep;
    const unsigned ldsw = (unsigned)wid * 1024u;
    const int aoff = lds_byte(wr * 64 + fr, fq * 8), boff = lds_byte(wc * 32 + fr, fq * 8);
#define PG8_SA(b, h) (((b) * 2 + (h)) * HTB)
#define PG8_SB(b, h) ((4 + (b) * 2 + (h)) * HTB)
#define PG8_STAGE(bufoff, gbase, voff) do { _Pragma("unroll") for (int _i = 0; _i < 2; ++_i) \
        __builtin_amdgcn_global_load_lds((const unsigned*)((const char*)(gbase) + (voff)[_i]), (PG8_LAS unsigned*)(lds + (bufoff) + ldsw + _i * 8192), 16, 0, 0); } while (0)
#define PG8_LDA(dst, b, h) do { _Pragma("unroll") for (int m = 0; m < 4; ++m) _Pragma("unroll") for (int k = 0; k < 2; ++k) dst[m][k] = *(const PG8_LAS bf16x8*)(lds + PG8_SA(b, h) + aoff + m * 2048 + k * 1024); } while (0)
#define PG8_LDB(dst, b, h) do { _Pragma("unroll") for (int n = 0; n < 2; ++n) _Pragma("unroll") for (int k = 0; k < 2; ++k) dst[n][k] = *(const PG8_LAS bf16x8*)(lds + PG8_SB(b, h) + boff + n * 2048 + k * 1024); } while (0)
#define PG8_MMA(ai, bj, At, Bt) do { __builtin_amdgcn_s_setprio(1); _Pragma("unroll") for (int m = 0; m < 4; ++m) _Pragma("unroll") for (int n = 0; n < 2; ++n) _Pragma("unroll") for (int k = 0; k < 2; ++k) \
        acc[ai][bj][m][n] = __builtin_amdgcn_mfma_f32_16x16x32_bf16(Bt[n][k], At[m][k], acc[ai][bj][m][n], 0, 0, 0); __builtin_amdgcn_s_setprio(0); } while (0)
#define PG8_WAIT_V(n) asm volatile("s_waitcnt vmcnt(" #n ")" ::: "memory")
#define PG8_WAIT_L(n) asm volatile("s_waitcnt lgkmcnt(" #n ")" ::: "memory")
#define PG8_BAR __builtin_amdgcn_s_barrier()
#define PG8_SCHED __builtin_amdgcn_sched_barrier(0)
    Unit cur, nxt; int ui = 0;
    if (!S.next(0, cur)) return;
    f32x4 acc[2][2][4][2];
#pragma unroll
    for (int a = 0; a < 2; ++a)
#pragma unroll
        for (int b = 0; b < 2; ++b)
#pragma unroll
            for (int m = 0; m < 4; ++m)
#pragma unroll
                for (int n = 0; n < 2; ++n) acc[a][b][m][n] = (f32x4){0.f, 0.f, 0.f, 0.f};
    bf16x8 At[4][2], B0[2][2], B1[2][2];
    const char* cA = (const char*)g.A + (size_t)cur.pm * tstep; const char* cB = (const char*)g.Bt + (size_t)cur.pn * tstep;
    S.a_ready(cur);
    if constexpr (SP2) {
        PG8_STAGE(PG8_SB(0, 0), cB, voffB); PG8_STAGE(PG8_SB(0, 1), cB + hstep, voffB); PG8_STAGE(PG8_SA(0, 0), cA, voffA); PG8_STAGE(PG8_SA(0, 1), cA + hstep, voffA);
        if (wr == 1) PG8_BAR;
        PG8_WAIT_V(2); PG8_BAR;
        PG8_STAGE(PG8_SB(1, 0), cB + kstep, voffB); PG8_STAGE(PG8_SA(1, 0), cA + kstep, voffA); PG8_STAGE(PG8_SB(1, 1), cB + hstep + kstep, voffB);
        PG8_WAIT_V(6); PG8_BAR;
    } else {
        PG8_STAGE(PG8_SB(0, 0), cB, voffB); PG8_STAGE(PG8_SA(0, 0), cA, voffA); PG8_STAGE(PG8_SB(0, 1), cB + hstep, voffB); PG8_STAGE(PG8_SA(0, 1), cA + hstep, voffA);
        if (wr == 1) PG8_BAR;
        PG8_WAIT_V(4); PG8_BAR;
        PG8_STAGE(PG8_SB(1, 0), cB + kstep, voffB); PG8_STAGE(PG8_SA(1, 0), cA + kstep, voffA); PG8_STAGE(PG8_SB(1, 1), cB + hstep + kstep, voffB);
        PG8_WAIT_V(6); PG8_BAR;
    }
    for (;;) {
        const bool has_next = S.next(ui + 1, nxt);
        const char* nA = has_next ? (const char*)g.A + (size_t)nxt.pm * tstep : cA; const char* nB = has_next ? (const char*)g.Bt + (size_t)nxt.pn * tstep : cB;
        for (int t = 0; t < nt; t += 2) {
            const bool last = (t == nt - 2);
            const char* a1 = cA + (size_t)(t + 1) * kstep;
            const char* a2 = last ? nA : cA + (size_t)(t + 2) * kstep; const char* b2 = last ? nB : cB + (size_t)(t + 2) * kstep;
            const char* a3 = a2 + kstep; const char* b3 = b2 + kstep;
            if (last && has_next) S.a_ready(nxt);
            if constexpr (SP2) {
            PG8_LDB(B0, 0, 0); PG8_LDB(B1, 0, 1); PG8_SCHED; PG8_LDA(At, 0, 0); PG8_STAGE(PG8_SA(1, 1), a1 + hstep, voffA);
            PG8_WAIT_V(8); PG8_WAIT_L(0); PG8_BAR; PG8_MMA(0, 0, At, B0); PG8_MMA(0, 1, At, B1); PG8_BAR; PG8_SCHED;
            PG8_LDA(At, 0, 1); PG8_STAGE(PG8_SB(0, 0), b2, voffB); PG8_STAGE(PG8_SB(0, 1), b2 + hstep, voffB); PG8_STAGE(PG8_SA(0, 0), a2, voffA);
            PG8_WAIT_V(8); PG8_WAIT_L(0); PG8_BAR; PG8_MMA(1, 0, At, B0); PG8_MMA(1, 1, At, B1); PG8_BAR; PG8_SCHED;
            PG8_LDB(B0, 1, 0); PG8_LDB(B1, 1, 1); PG8_SCHED; PG8_LDA(At, 1, 0); PG8_STAGE(PG8_SA(0, 1), a2 + hstep, voffA);
            PG8_WAIT_V(8); PG8_WAIT_L(0); PG8_BAR; PG8_MMA(0, 0, At, B0); PG8_MMA(0, 1, At, B1); PG8_BAR; PG8_SCHED;
            PG8_LDA(At, 1, 1); PG8_STAGE(PG8_SB(1, 0), b3, voffB); PG8_STAGE(PG8_SB(1, 1), b3 + hstep, voffB); PG8_STAGE(PG8_SA(1, 0), a3, voffA);
            PG8_WAIT_V(8); PG8_WAIT_L(0); PG8_BAR; PG8_MMA(1, 0, At, B0); PG8_MMA(1, 1, At, B1); PG8_BAR; PG8_SCHED;
            } else {
            PG8_LDB(B0, 0, 0); PG8_SCHED; PG8_LDA(At, 0, 0); PG8_STAGE(PG8_SA(1, 1), a1 + hstep, voffA);
            PG8_WAIT_L(8); PG8_BAR; PG8_WAIT_L(0); PG8_MMA(0, 0, At, B0); PG8_BAR; PG8_SCHED;
            PG8_LDB(B1, 0, 1); PG8_STAGE(PG8_SB(0, 0), b2, voffB);
            PG8_BAR; PG8_WAIT_L(0); PG8_MMA(0, 1, At, B1); PG8_BAR;
            PG8_LDA(At, 0, 1); PG8_STAGE(PG8_SA(0, 0), a2, voffA);
            PG8_BAR; PG8_WAIT_L(0); PG8_MMA(1, 0, At, B0); PG8_BAR; PG8_SCHED;
            PG8_STAGE(PG8_SB(0, 1), b2 + hstep, voffB);
            PG8_WAIT_V(6); PG8_BAR; PG8_MMA(1, 1, At, B1); PG8_BAR;
            PG8_LDB(B0, 1, 0); PG8_SCHED; PG8_LDA(At, 1, 0); PG8_STAGE(PG8_SA(0, 1), a2 + hstep, voffA);
            PG8_WAIT_L(8); PG8_BAR; PG8_WAIT_L(0); PG8_MMA(0, 0, At, B0); PG8_BAR; PG8_SCHED;
            PG8_LDB(B1, 1, 1); PG8_STAGE(PG8_SB(1, 0), b3, voffB);
            PG8_BAR; PG8_WAIT_L(0); PG8_MMA(0, 1, At, B1); PG8_BAR;
            PG8_LDA(At, 1, 1); PG8_STAGE(PG8_SA(1, 0), a3, voffA);
            PG8_BAR; PG8_WAIT_L(0); PG8_MMA(1, 0, At, B0); PG8_BAR; PG8_SCHED;
            PG8_STAGE(PG8_SB(1, 1), b3 + hstep, voffB);
            PG8_WAIT_V(6); PG8_BAR; PG8_MMA(1, 1, At, B1); PG8_BAR;
            }
        }
        if constexpr (ALIGN_EPI) { if (wr == 0) PG8_BAR; }
        if constexpr (!Epi::AFTER_DRAIN) { E(acc, cur, wr, wc, fr, fq); S.done(cur); }
        if (!has_next) break;
#pragma unroll
        for (int a = 0; a < 2; ++a)
#pragma unroll
            for (int b = 0; b < 2; ++b)
#pragma unroll
                for (int m = 0; m < 4; ++m)
#pragma unroll
                    for (int n = 0; n < 2; ++n) acc[a][b][m][n] = (f32x4){0.f, 0.f, 0.f, 0.f};
        cur = nxt; cA = nA; cB = nB; ++ui;
        if constexpr (ALIGN_EPI) { if (wr == 1) PG8_BAR; }
    }
    PG8_WAIT_V(0);
    if constexpr (!ALIGN_EPI) { if (wr == 0) PG8_BAR; }
    PG8_BAR;
    if constexpr (Epi::AFTER_DRAIN) { E.fused(acc, cur, wr, wc, fr, fq, lds, wid, lane); S.done(cur); }
#undef PG8_SA
#undef PG8_SB
#undef PG8_STAGE
#undef PG8_LDA
#undef PG8_LDB
#undef PG8_MMA
#undef PG8_WAIT_V
#undef PG8_WAIT_L
#undef PG8_BAR
#undef PG8_SCHED
}
}

namespace attn_body {
using bf16=__hip_bfloat16;
using bf16x8=__attribute__((ext_vector_type(8)))short;
using s16x4=__attribute__((ext_vector_type(4)))short;
using f32x16=__attribute__((ext_vector_type(16)))float;
using u32x4=__attribute__((ext_vector_type(4)))unsigned;
constexpr int D=64,QP=4096,OP=2048;
constexpr int NW=8,QBLK=32,QB=QBLK*NW,KVBLK=64;
constexpr int ATTN_UNIT_ROWS=QB;
__device__ __forceinline__ int crow(int r,int hi){return (r&3)+8*(r>>2)+4*hi;}
#define SBAR() __builtin_amdgcn_sched_barrier(0)
__device__ __forceinline__ void cmask(f32x16&p0,f32x16&p1,int jb,int qrel,int hi){
  const float NEG=-INFINITY; int kb=64*jb+4*hi;
  #pragma unroll
  for(int r=0;r<16;++r){int kv=kb+(r&3)+8*(r>>2); if(kv>qrel)p0[r]=NEG; if(kv+32>qrel)p1[r]=NEG;}
}

constexpr int NSLOT=3, SLOTB=8192;
constexpr int LDS_K=0, LDS_V=NSLOT*SLOTB, LDS_WS=2*NSLOT*SLOTB, LDS_OST=LDS_WS+NW*64*4, LDS_BYTES=LDS_OST+NW*4096;
constexpr float C2=0.125f*1.4426950408889634f;
__device__ __forceinline__ void glds16(const void*gsrc,unsigned lds_dst){unsigned keep;
  asm volatile("s_mov_b32 %0, m0\n\ts_mov_b32 m0, %2\n\ts_nop 0\n\tglobal_load_lds_dwordx4 %1, off\n\ts_mov_b32 m0, %0":"=&s"(keep):"v"(gsrc),"s"(lds_dst):"memory");}
__device__ __forceinline__ float max3f(float a,float b,float c){float r;asm("v_max3_f32 %0, %1, %2, %3":"=v"(r):"v"(a),"v"(b),"v"(c));return r;}
__device__ __forceinline__ float max2f(float a,float b){float r;asm("v_max_f32_e32 %0, %1, %2":"=v"(r):"v"(a),"v"(b));return r;}
__device__ __forceinline__ float fadd_s(float a,float b){float r;asm("v_add_f32_e32 %0, %1, %2":"=v"(r):"v"(a),"v"(b));return r;}
__device__ __forceinline__ float fsub_s(float a,float b){float r;asm("v_sub_f32_e32 %0, %1, %2":"=v"(r):"v"(a),"v"(b));return r;}
typedef float f32x2_t __attribute__((ext_vector_type(2))); typedef __bf16 bf16x2_t __attribute__((ext_vector_type(2)));
__device__ __forceinline__ unsigned cvtpk_s(float lo,float hi){f32x2_t v={lo,hi};bf16x2_t b=__builtin_convertvector(v,bf16x2_t);return __builtin_bit_cast(unsigned,b);}
#define WAIT_BAR(N) asm volatile("s_waitcnt vmcnt(" #N ") lgkmcnt(0)\n\ts_barrier":::"memory")

__device__ __forceinline__ void qkt(f32x16&p0,f32x16&p1,const char*Kslot,const bf16x8*qr,const f32x16&negm,int r32,int hi){
  const char*kb=Kslot+hi*1024+r32*16;
  #pragma unroll
  for(int d0=0;d0<4;++d0){
    const bf16x8 b0=*reinterpret_cast<const bf16x8*>(kb+d0*2048);
    const bf16x8 b1=*reinterpret_cast<const bf16x8*>(kb+d0*2048+512);
    if(d0==0){p0=__builtin_amdgcn_mfma_f32_32x32x16_bf16(b0,qr[0],negm,0,0,0);p1=__builtin_amdgcn_mfma_f32_32x32x16_bf16(b1,qr[0],negm,0,0,0);}
    else{p0=__builtin_amdgcn_mfma_f32_32x32x16_bf16(b0,qr[d0],p0,0,0,0);p1=__builtin_amdgcn_mfma_f32_32x32x16_bf16(b1,qr[d0],p1,0,0,0);}}
}
typedef __attribute__((address_space(3))) const char* lds_cptr;
typedef short v4i16_t __attribute__((ext_vector_type(4)));
__device__ __forceinline__ void kload8(bf16x8*kf,lds_cptr kp){
  kf[0]=*(const __attribute__((address_space(3))) bf16x8*)(kp);      kf[1]=*(const __attribute__((address_space(3))) bf16x8*)(kp+512);
  kf[2]=*(const __attribute__((address_space(3))) bf16x8*)(kp+2048); kf[3]=*(const __attribute__((address_space(3))) bf16x8*)(kp+2560);
  kf[4]=*(const __attribute__((address_space(3))) bf16x8*)(kp+4096); kf[5]=*(const __attribute__((address_space(3))) bf16x8*)(kp+4608);
  kf[6]=*(const __attribute__((address_space(3))) bf16x8*)(kp+6144); kf[7]=*(const __attribute__((address_space(3))) bf16x8*)(kp+6656);
}
__device__ __forceinline__ void kload2(bf16x8*kf,lds_cptr kp,int j){ kf[2*j]=*(const __attribute__((address_space(3))) bf16x8*)(kp+j*2048); kf[2*j+1]=*(const __attribute__((address_space(3))) bf16x8*)(kp+j*2048+512); }
__device__ __forceinline__ s16x4 vtr(lds_cptr p){ return __builtin_bit_cast(s16x4,__builtin_amdgcn_ds_read_tr16_b64_v4i16((__attribute__((address_space(3))) v4i16_t*)p)); }
__device__ __forceinline__ float rowmax(const f32x16&p0,const f32x16&p1){
  float a=max3f(p0[0],p0[1],p1[0]),b=max3f(p0[2],p0[3],p1[1]);a=max3f(a,p1[2],p1[3]);
  #pragma unroll
  for(int r=4;r<16;r+=4){a=max3f(a,p0[r],p0[r+1]);b=max3f(b,p0[r+2],p0[r+3]);a=max3f(a,p1[r],p1[r+1]);b=max3f(b,p1[r+2],p1[r+3]);}
  const float m=max2f(a,b);
  auto rr=__builtin_amdgcn_permlane32_swap(__float_as_uint(m),__float_as_uint(m),false,false);
  return max2f(__uint_as_float(rr[0]),__uint_as_float(rr[1]));
}
__device__ __forceinline__ void pv(f32x16*o,int vb,bf16x8 pa0,bf16x8 pa1,bf16x8 pa2,bf16x8 pa3){
  #pragma unroll
  for(int d0=0;d0<2;++d0){s16x4 lo[4],hi[4];
    #pragma unroll
    for(int ks=0;ks<4;++ks){
      asm volatile("ds_read_b64_tr_b16 %0,%1 offset:%c2":"=&v"(lo[ks]):"v"(vb),"i"(d0*4096+ks*1024):"memory");
      asm volatile("ds_read_b64_tr_b16 %0,%1 offset:%c2":"=&v"(hi[ks]):"v"(vb),"i"(d0*4096+ks*1024+512):"memory");}
    asm volatile("s_waitcnt lgkmcnt(0)":::"memory");SBAR();
    #define PK(k) (bf16x8){lo[k][0],lo[k][1],lo[k][2],lo[k][3],hi[k][0],hi[k][1],hi[k][2],hi[k][3]}
    o[d0]=__builtin_amdgcn_mfma_f32_32x32x16_bf16(pa0,PK(0),o[d0],0,0,0);
    o[d0]=__builtin_amdgcn_mfma_f32_32x32x16_bf16(pa1,PK(1),o[d0],0,0,0);
    o[d0]=__builtin_amdgcn_mfma_f32_32x32x16_bf16(pa2,PK(2),o[d0],0,0,0);
    o[d0]=__builtin_amdgcn_mfma_f32_32x32x16_bf16(pa3,PK(3),o[d0],0,0,0);
    #undef PK
  }
}

#ifndef ATTN_STORE16
#define ATTN_STORE16(p,v) (*(u32x4*)(p)=(v))
#endif
template<int THRL> __device__ __forceinline__ void attn_unit(int qb,const bf16*Q0,const bf16*__restrict__ Kh,const bf16*__restrict__ Vh,bf16*O0,char*shm){
  int tid_=threadIdx.x; asm volatile("":"+v"(tid_));
  const int tid=tid_,lane=tid&63,r32=lane&31,hi=lane>>5; const int wid=__builtin_amdgcn_readfirstlane(tid>>6);
  const bf16*Qw=Q0+(long)(wid*QBLK)*QP;
  const unsigned lds0=(unsigned)(uintptr_t)shm;
  float*wsf=(float*)(shm+LDS_WS)+wid*64;
  const bf16*ksrc=Kh+(long)lane*QP+wid*8;
  const bf16*vsrc=Vh+(long)(16*(wid&3)+(lane>>2))*QP+(wid>>2)*32+(lane&3)*8;
  const unsigned kdst=lds0+LDS_K+wid*1024, vdst=lds0+LDS_V+wid*1024;
  #define DMA_K(t,slot) glds16(ksrc+(long)(t)*KVBLK*QP,(unsigned)__builtin_amdgcn_readfirstlane(kdst+(slot)))
  #define DMA_V(t,slot) glds16(vsrc+(long)(t)*KVBLK*QP,(unsigned)__builtin_amdgcn_readfirstlane(vdst+(slot)))
  const int vb0=(int)(lds0+LDS_V)+((lane>>4)&1)*32+(lane&3)*8+(4*hi+((lane&15)>>2))*64;
  const char*Kbase=shm+LDS_K; bf16x8 kf[8];
  const lds_cptr shm3=(lds_cptr)shm; const lds_cptr kp0=shm3+LDS_K+hi*1024+r32*16; const lds_cptr vp0=shm3+LDS_V+((lane>>4)&1)*32+(lane&3)*8+(4*hi+((lane&15)>>2))*64;
  const int NT=4*qb+5;
  DMA_K(0,0);DMA_V(0,0);DMA_K(1,SLOTB);
  bf16x8 qr[4];
  #pragma unroll
  for(int d0=0;d0<4;++d0)qr[d0]=*reinterpret_cast<const bf16x8*>(&Qw[(long)r32*QP+d0*16+hi*8]);
  float mhat=0.f,l_reg=0.f;f32x16 o[2];o[0]=f32x16{};o[1]=f32x16{};f32x16 negm=f32x16{};asm volatile("":"+v"(negm));
  const int qrel=wid*QBLK+r32;
  #define CMASK(P0,P1,t) do{int jb_=(t)-(NT-4); if(jb_>=0)cmask(P0,P1,jb_,qrel,hi);}while(0)
  bool resc=false;
  #define START(P0,P1) do{ const float rm=rowmax(P0,P1); resc=false; \
    { const float dl=rm; mhat=fadd_s(mhat,dl); \
      _Pragma("unroll") for(int r=0;r<16;++r){P0[r]=fsub_s(P0[r],dl);P1[r]=fsub_s(P1[r],dl);} \
      _Pragma("unroll") for(int r=0;r<16;++r)negm[r]=-mhat; asm volatile("":"+v"(negm)); } \
    _Pragma("unroll") for(int r=0;r<16;++r)P0[r]=__builtin_amdgcn_exp2f(P0[r]); }while(0)
  #define RESC() do{ if(resc){ asm volatile("s_waitcnt lgkmcnt(0)":::"memory"); \
      _Pragma("unroll") for(int d_=0;d_<2;++d_) _Pragma("unroll") for(int r=0;r<16;++r)o[d_][r]*=wsf[crow(r,hi)]; } }while(0)
  f32x16 pA0,pA1,pB0,pB1;
  int sl_prev=0,sl_cur=0,sl_next=SLOTB;
  #define ROT() do{sl_prev=sl_cur;sl_cur=sl_next;sl_next=(sl_next==(NSLOT-1)*SLOTB)?0:sl_next+SLOTB;}while(0)
  DMA_K(2,2*SLOTB);
  WAIT_BAR(3);
  qkt(pA0,pA1,Kbase,qr,negm,r32,hi);asm volatile("s_nop 15\n\ts_nop 7":"+v"(pA0),"+v"(pA1));
  { const float NEGI=-INFINITY;
    _Pragma("unroll") for(int r=0;r<16;++r)pA0[r]=NEGI;
    _Pragma("unroll") for(int r=0;r<8;++r)pA1[r]=NEGI; }
  START(pA0,pA1);
  _Pragma("unroll") for(int r=0;r<16;++r)pA1[r]=__builtin_amdgcn_exp2f(pA1[r]);
  WAIT_BAR(0);
  DMA_K(3,0);DMA_V(1,SLOTB);
  ROT();
  kload8(kf,kp0+sl_cur);
  WAIT_BAR(2);
  s16x4 vlo[8],vhi[8]; u32x4 pw0,pw1,pw2,pw3;
  #define PKW(P,B) cvtpk_s(P[B],P[B+1])
  #define PAF(k) __builtin_bit_cast(bf16x8,pw##k)
  #define VFR(i) (bf16x8){vlo[i][0],vlo[i][1],vlo[i][2],vlo[i][3],vhi[i][0],vhi[i][1],vhi[i][2],vhi[i][3]}
  #define PIN(x) asm volatile("":"+v"(x))
  #define MX3(a,b,c) __builtin_fmaxf(__builtin_fmaxf((a),(b)),(c))
  #define GAPA(MF,A0,A1,A2,A3,W0,W1,PW) do{ MF; sacc+=A0; sacc+=A1; sacc+=A2; sacc+=A3; PIN(sacc); W0; W1; PIN(PW); SBAR(); }while(0)
  #define EX(v) __builtin_amdgcn_exp2f(v)
  #define GAPB(MF,X,B) do{ MF; X[B]=EX(X[B]); X[B+1]=EX(X[B+1]); X[B+2]=EX(X[B+2]); X[B+3]=EX(X[B+3]); PIN(X); SBAR(); }while(0)
  #define VRD(i) do{ vlo[i]=vtr(vp_+(((i)>>2)*4096+((i)&3)*1024)); vhi[i]=vtr(vp_+(((i)>>2)*4096+((i)&3)*1024+512)); }while(0)
  #define KRD(G,j) do{ if(G){ kload2(kf,kp0+sl_next,j); SBAR(); } }while(0)
  #define STEP(C0,C1,P0,P1,t,GK,GV,GL) do{ SBAR(); \
    const lds_cptr vp_=vp0+sl_prev; \
    VRD(0); SBAR(); float sacc=(P0[0]+P0[1]); \
    GAPA(C0=__builtin_amdgcn_mfma_f32_32x32x16_bf16(kf[0],qr[0],negm,0,0,0), P0[2],P0[3],P0[4],P0[5],     pw0[0]=PKW(P0,0), pw0[1]=PKW(P0,2), pw0); \
    VRD(4); SBAR(); GAPA(C1=__builtin_amdgcn_mfma_f32_32x32x16_bf16(kf[1],qr[0],negm,0,0,0), P0[6],P0[7],P0[8],P0[9],     pw0[2]=PKW(P0,4), pw0[3]=PKW(P0,6), pw0); \
    VRD(1); SBAR(); GAPA(C0=__builtin_amdgcn_mfma_f32_32x32x16_bf16(kf[2],qr[1],C0,0,0,0),   P0[10],P0[11],P0[12],P0[13], pw1[0]=PKW(P0,8), pw1[1]=PKW(P0,10), pw1); \
    VRD(5); SBAR(); GAPA(C1=__builtin_amdgcn_mfma_f32_32x32x16_bf16(kf[3],qr[1],C1,0,0,0),   P0[14],P0[15],P1[0],P1[1],   pw1[2]=PKW(P0,12),pw1[3]=PKW(P0,14), pw1); \
    VRD(2); SBAR(); GAPA(C0=__builtin_amdgcn_mfma_f32_32x32x16_bf16(kf[4],qr[2],C0,0,0,0),   P1[2],P1[3],P1[4],P1[5],     pw2[0]=PKW(P1,0), pw2[1]=PKW(P1,2), pw2); \
    VRD(6); SBAR(); GAPA(C1=__builtin_amdgcn_mfma_f32_32x32x16_bf16(kf[5],qr[2],C1,0,0,0),   P1[6],P1[7],P1[8],P1[9],     pw2[2]=PKW(P1,4), pw2[3]=PKW(P1,6), pw2); \
    VRD(3); SBAR(); GAPA(C0=__builtin_amdgcn_mfma_f32_32x32x16_bf16(kf[6],qr[3],C0,0,0,0),   P1[10],P1[11],P1[12],P1[13], pw3[0]=PKW(P1,8), pw3[1]=PKW(P1,10), pw3); \
    VRD(7); SBAR(); GAPA(C1=__builtin_amdgcn_mfma_f32_32x32x16_bf16(kf[7],qr[3],C1,0,0,0),   P1[14],P1[15],0.f,0.f,       pw3[2]=PKW(P1,12),pw3[3]=PKW(P1,14), pw3); \
    l_reg+=sacc; \
    if(GK){DMA_K((t)+3,sl_cur);} if(GV){DMA_V((t)+1,sl_next);} \
    CMASK(C0,C1,t); \
    { float a=MX3(C0[0],C0[1],C1[0]),b=MX3(C0[2],C0[3],C1[1]); a=MX3(a,C1[2],C1[3]); \
      _Pragma("unroll") for(int r=4;r<16;r+=4){a=MX3(a,C0[r],C0[r+1]);b=MX3(b,C0[r+2],C0[r+3]);a=MX3(a,C1[r],C1[r+1]);b=MX3(b,C1[r+2],C1[r+3]);} \
      float rm=__builtin_fmaxf(a,b); { auto rr=__builtin_amdgcn_permlane32_swap(__float_as_uint(rm),__float_as_uint(rm),false,false); rm=__builtin_fmaxf(__uint_as_float(rr[0]),__uint_as_float(rr[1])); } \
      resc=false; \
      if(__builtin_expect(__any(rm>(float)THRL),0)){ const float dl=__builtin_fmaxf(rm,0.f); mhat+=dl; \
        _Pragma("unroll") for(int r=0;r<16;++r){C0[r]-=dl;C1[r]-=dl;} \
        _Pragma("unroll") for(int r=0;r<16;++r)negm[r]=-mhat; asm volatile("":"+v"(negm)); \
        const float f=__builtin_amdgcn_exp2f(-dl); l_reg*=f; if(hi==0)wsf[r32]=f; resc=true; } } \
    SBAR(); \
    GAPB(o[0]=__builtin_amdgcn_mfma_f32_32x32x16_bf16(PAF(0),VFR(0),o[0],0,0,0), C0,0); \
    GAPB(o[1]=__builtin_amdgcn_mfma_f32_32x32x16_bf16(PAF(0),VFR(4),o[1],0,0,0), C0,4); \
    KRD(GL,0); GAPB(o[0]=__builtin_amdgcn_mfma_f32_32x32x16_bf16(PAF(1),VFR(1),o[0],0,0,0), C0,8); \
    KRD(GL,1); GAPB(o[1]=__builtin_amdgcn_mfma_f32_32x32x16_bf16(PAF(1),VFR(5),o[1],0,0,0), C0,12); \
    KRD(GL,2); GAPB(o[0]=__builtin_amdgcn_mfma_f32_32x32x16_bf16(PAF(2),VFR(2),o[0],0,0,0), C1,0); \
    KRD(GL,3); GAPB(o[1]=__builtin_amdgcn_mfma_f32_32x32x16_bf16(PAF(2),VFR(6),o[1],0,0,0), C1,4); \
    GAPB(o[0]=__builtin_amdgcn_mfma_f32_32x32x16_bf16(PAF(3),VFR(3),o[0],0,0,0), C1,8); \
    GAPB(o[1]=__builtin_amdgcn_mfma_f32_32x32x16_bf16(PAF(3),VFR(7),o[1],0,0,0), C1,12); \
    }while(0)
  int t=1;
  #undef CMASK
  #define CMASK(P0,P1,t) do{}while(0)
  for(;t+5<NT;t+=2){
    STEP(pB0,pB1,pA0,pA1,t,true,true,true);     WAIT_BAR(2); RESC(); ROT();
    STEP(pA0,pA1,pB0,pB1,t+1,true,true,true);   WAIT_BAR(2); RESC(); ROT();
  }
  #undef CMASK
  #define CMASK(P0,P1,t) do{int jb_=(t)-(NT-4); if(jb_>=0)cmask(P0,P1,jb_,qrel,hi);}while(0)
  #define ENDW(tt) do{ if((tt)+3<NT){WAIT_BAR(2);} else if((tt)+2<NT){WAIT_BAR(1);} else {WAIT_BAR(0);} }while(0)
  for(;t+3<NT;t+=2){
    STEP(pB0,pB1,pA0,pA1,t,(t+3<NT),(t+1<NT),(t+1<NT));       ENDW(t);   RESC(); ROT();
    STEP(pA0,pA1,pB0,pB1,t+1,(t+4<NT),(t+2<NT),(t+2<NT));     ENDW(t+1); RESC(); ROT();
  }
  STEP(pB0,pB1,pA0,pA1,t,false,true,true);        WAIT_BAR(0); RESC(); ROT();
  STEP(pA0,pA1,pB0,pB1,NT-1,false,false,false); RESC();
  { float sacc=pA0[0]+pA0[1]; _Pragma("unroll") for(int r=2;r<16;++r)sacc+=pA0[r]; _Pragma("unroll") for(int r=0;r<16;++r)sacc+=pA1[r]; l_reg+=sacc;
    pw0=(u32x4){PKW(pA0,0),PKW(pA0,2),PKW(pA0,4),PKW(pA0,6)};pw1=(u32x4){PKW(pA0,8),PKW(pA0,10),PKW(pA0,12),PKW(pA0,14)};pw2=(u32x4){PKW(pA1,0),PKW(pA1,2),PKW(pA1,4),PKW(pA1,6)};pw3=(u32x4){PKW(pA1,8),PKW(pA1,10),PKW(pA1,12),PKW(pA1,14)};
    SBAR(); pv(o,vb0+sl_cur,PAF(0),PAF(1),PAF(2),PAF(3)); }
  #undef PKW
  #undef PAF
  #undef VFR
  #undef PIN
  #undef MX3
  #undef GAPA
  #undef GAPB
  #undef EX
  #undef VRD
  #undef KRD
  #undef STEP
  #undef ENDW
  {auto rr=__builtin_amdgcn_permlane32_swap(__float_as_uint(l_reg),__float_as_uint(l_reg),false,false);l_reg=__uint_as_float(rr[0])+__uint_as_float(rr[1]);}
  if(hi==0)wsf[32+r32]=l_reg;asm volatile("s_waitcnt lgkmcnt(0)":::"memory");
  float rli[16];
  #pragma unroll
  for(int r=0;r<16;++r)rli[r]=__builtin_amdgcn_rcpf(wsf[32+crow(r,hi)]);
  bf16*Ow=O0+(long)(wid*QBLK)*OP;
  { bf16*stg=(bf16*)(shm+LDS_OST)+wid*2048;
    #pragma unroll
    for(int r=0;r<16;++r){const int orow=crow(r,hi);
      #pragma unroll
      for(int d0=0;d0<2;++d0)stg[orow*64+d0*32+r32]=__float2bfloat16(o[d0][r]*rli[r]);}
    asm volatile("s_waitcnt lgkmcnt(0)":::"memory");
    #pragma unroll
    for(int i=0;i<4;++i){const int row=i*8+(lane>>3),ch=lane&7; const u32x4 v=*(const u32x4*)(stg+row*64+ch*8); ATTN_STORE16(Ow+(long)row*OP+ch*8,v);} }
  asm volatile("s_waitcnt lgkmcnt(0)\n\ts_barrier":::"memory");
  #undef DMA_K
  #undef DMA_V
  #undef CMASK
  #undef START
  #undef RESC
  #undef ROT
}
constexpr int ATTN_LDS_BYTES=LDS_BYTES;
#undef SBAR
#undef WAIT_BAR
}

#define GAS __attribute__((address_space(1)))
#define LAS __attribute__((address_space(3)))
typedef unsigned short bf16;
typedef unsigned v4u __attribute__((ext_vector_type(4)));
typedef float f32x4 __attribute__((ext_vector_type(4)));
typedef short bf16x8 __attribute__((ext_vector_type(8)));
typedef GAS unsigned gu32;
typedef GAS unsigned long long gu64;
#define RLX_AGENT __ATOMIC_RELAXED, __HIP_MEMORY_SCOPE_AGENT
#define LDS_WAIT() asm volatile("s_waitcnt lgkmcnt(0)" ::: "memory")
#define VM_WAIT() asm volatile("s_waitcnt vmcnt(0)" ::: "memory")
__device__ __forceinline__ unsigned long long rt() { return __builtin_amdgcn_s_memrealtime(); }
__device__ __forceinline__ unsigned f2bf(float f) { unsigned u = __builtin_bit_cast(unsigned, f); return (u + 0x7fffu + ((u >> 16) & 1u)) >> 16; }
__device__ __forceinline__ unsigned pk2(float lo, float hi) { return f2bf(lo) | (f2bf(hi) << 16); }

#define XB_TMO      128
#define XB_XCNT(j)  (256  + 64 * (j))
#define XB_XSUB(j)  (1280 + 64 * (j))
#define XB_XGEN(j)  (2304 + 64 * (j))
#define XB_TOP      3328
#define XB_TOPGEN   3392
#define XCD_BAR_WORDS 3456
#define XB_SPIN_CAP (1u << 18)

__device__ __forceinline__ unsigned xb_ld(unsigned* p)              { return __hip_atomic_load(p, __ATOMIC_RELAXED, __HIP_MEMORY_SCOPE_AGENT); }
__device__ __forceinline__ unsigned xb_add(unsigned* p, unsigned v) { return __hip_atomic_fetch_add(p, v, __ATOMIC_RELAXED, __HIP_MEMORY_SCOPE_AGENT); }
__device__ __forceinline__ unsigned xb_xcc_id() { return (unsigned)__builtin_amdgcn_s_getreg((3 << 11) | 20) & 0xFu; }
#define XB_SPIN(cond, bar) do { unsigned _sp = 0; while (cond) { __builtin_amdgcn_s_sleep(1); \
    if ((++_sp & 255u) == 0u) { if (xb_ld(&(bar)[XB_TMO])) break; if (_sp > XB_SPIN_CAP) { atomicAdd(&(bar)[XB_TMO], 1u); break; } } } } while (0)

struct XcdBarrier {
    unsigned* bar; unsigned x;
    volatile LAS unsigned* st;
};

__device__ __forceinline__ XcdBarrier xcd_barrier_post(unsigned* bar, volatile LAS unsigned* st) {
    XcdBarrier b; b.bar = bar; b.x = xb_xcc_id(); b.st = st;
    if (threadIdx.x == 0) (void)xb_add(&bar[XB_XCNT(b.x)], 1u);
    return b;
}
__device__ __forceinline__ void xcd_barrier_complete(unsigned* bar, unsigned x, unsigned& nloc, unsigned& nx) {
    const unsigned G = gridDim.x * gridDim.y * gridDim.z;
    unsigned sum, cnt, mine, sp = 0u;
    for (;;) {
        sum = 0u; cnt = 0u; mine = 0u;
#pragma unroll
        for (unsigned j = 0; j < 16; ++j) { const unsigned c = xb_ld(&bar[XB_XCNT(j)]); sum += c; cnt += (c > 0u) ? 1u : 0u; mine = (j == x) ? c : mine; }
        if (sum == G) break;
        __builtin_amdgcn_s_sleep(1);
        if ((++sp & 255u) == 0u) { if (xb_ld(&bar[XB_TMO])) break; if (sp > XB_SPIN_CAP) { atomicAdd(&bar[XB_TMO], 1u); break; } }
    }
    nloc = mine > 0u ? mine : 1u; nx = cnt > 0u ? cnt : 1u;
}

__device__ __forceinline__ void xcd_barrier(const XcdBarrier& b) {
    asm volatile("s_waitcnt vmcnt(0)" ::: "memory");
    __syncthreads();
    if (threadIdx.x == 0) {
        unsigned* bar = b.bar;
        __builtin_amdgcn_s_waitcnt(0);
        unsigned nloc = b.st[0], nx = b.st[1];
        if (nloc == 0u) { xcd_barrier_complete(bar, b.x, nloc, nx); b.st[0] = nloc; b.st[1] = nx; }
        const unsigned old = xb_add(&bar[XB_XSUB(b.x)], 1u);
        const unsigned gen = old / nloc;
        if (old + 1u == (gen + 1u) * nloc) {
            __builtin_amdgcn_fence(__ATOMIC_RELEASE, "agent");
            asm volatile("s_waitcnt vmcnt(0)" ::: "memory");
            const unsigned og = xb_add(&bar[XB_TOP], 1u);
            const unsigned tg = og / nx;
            if (og + 1u == (tg + 1u) * nx) xb_add(&bar[XB_TOPGEN], 1u);
            else XB_SPIN(xb_ld(&bar[XB_TOPGEN]) == tg, bar);
            __builtin_amdgcn_fence(__ATOMIC_ACQUIRE, "agent");
            xb_add(&bar[XB_XGEN(b.x)], 1u);
            asm volatile("s_waitcnt vmcnt(0)" ::: "memory");
        } else {
            XB_SPIN(xb_ld(&bar[XB_XGEN(b.x)]) == gen, bar);
            __builtin_amdgcn_fence(__ATOMIC_ACQUIRE, "agent");
            asm volatile("s_waitcnt vmcnt(0)" ::: "memory");
        }
    }
    __syncthreads();
}

constexpr size_t MiB = 1u << 20;
constexpr size_t WS_CTL = 0, CTL_ZERO_BYTES = 1 * MiB;
constexpr size_t WS_ROPE = 1 * MiB;
constexpr size_t WS_SSQ = 2 * MiB;
constexpr size_t SSQ_SET = (size_t)8 * MROWS * 4;
constexpr size_t WS_H = 16 * MiB;
constexpr size_t WS_HB = 274 * MiB;
constexpr size_t WS_BIG = 403 * MiB;
constexpr size_t WS_PROJ = WS_BIG, WS_CAT = WS_BIG + 264 * MiB, WS_MID = WS_BIG;
constexpr size_t WS_TFOLD = WS_CAT;
constexpr size_t WS_WTS = 796 * MiB;
constexpr size_t WL_GU1 = 0, WL_D1 = 44 * MiB, WL_IN = 66 * MiB, WL_OUT = 82 * MiB, WL_GU2 = 90 * MiB, WL_D2 = 134 * MiB, WL_BYTES = 156 * MiB;
constexpr size_t WS_END = WS_WTS + 4 * WL_BYTES;
static_assert(SSQ_SET * 13 <= 14 * MiB && (size_t)MROWS * D_ * 4 <= 258 * MiB && (size_t)MROWS * D_ * 2 <= 129 * MiB && (size_t)MROWS * FF_ * 2 <= 393 * MiB && (size_t)VROWS * INW * 2 <= 264 * MiB, "d_ws map");
static_assert((size_t)2 * FF_ * D_ * 2 <= 44 * MiB && (size_t)D_ * FF_ * 2 <= 22 * MiB && (size_t)INW * D_ * 2 <= 16 * MiB && (size_t)D_ * D_ * 2 <= 8 * MiB, "weight map");
constexpr int CW_BAR = 4096;
constexpr int NPHASE = 2 + 8 * DEPTH + 1;

constexpr int RING_OFF = 0, RING_BYTES = 131072;
constexpr int LDSCTL_OFF = RING_BYTES;
constexpr int XR_OFF = LDSCTL_OFF, MISC_OFF = LDSCTL_OFF + 4352;
constexpr int LDS_BYTES = 147456;
static_assert(MISC_OFF + 128 <= LDS_BYTES, "LDS map");
constexpr int NWAVES = 8;

struct Args { const float* in[21]; float* out; unsigned char* ws; int ph_lo, ph_hi; float lam_init[4]; };
struct Frame {
    LAS unsigned char* lds; volatile LAS unsigned* MISC; gu32* ctl;
    int wave, vcu, G;
};
__device__ __forceinline__ float wave_sum(float v) {
#pragma unroll
    for (int o = 1; o < 64; o <<= 1) v += __shfl_xor(v, o);
    return v;
}
__device__ __forceinline__ float bf_lo(unsigned w) { return __builtin_bit_cast(float, w << 16); }
__device__ __forceinline__ float bf_hi(unsigned w) { return __builtin_bit_cast(float, w & 0xffff0000u); }

__device__ __forceinline__ void fold_item(const float* w_in, const float* w_pool, const float* pool_scale, float* T, int item, int lane) {
    const int k0 = (item & 255) * 8, g = (item >> 8) & 3, L = item >> 10;
    const float* A = w_in + ((size_t)L * D_ + k0) * INW + 3072 + 256 * g;
    const float* Bm = w_pool + ((size_t)(L * 4 + g) * 256) * 256 + 4 * lane;
    f32x4 acc[8];
#pragma unroll
    for (int r = 0; r < 8; ++r) acc[r] = (f32x4){0.f, 0.f, 0.f, 0.f};
    for (int cc = 0; cc < 256; cc += 4) {
        f32x4 b[4];
#pragma unroll
        for (int q = 0; q < 4; ++q) b[q] = *(const f32x4*)(Bm + (size_t)(cc + q) * 256);
#pragma unroll
        for (int r = 0; r < 8; ++r) { const f32x4 a = *(const f32x4*)(A + (size_t)r * INW + cc);
            acc[r] = acc[r] + b[0] * a[0] + b[1] * a[1] + b[2] * a[2] + b[3] * a[3]; }
    }
    const f32x4 sc = *(const f32x4*)(pool_scale + (size_t)L * 1024 + 256 * g + 4 * lane);
#pragma unroll
    for (int r = 0; r < 8; ++r) *(f32x4*)(T + ((size_t)L * D_ + k0 + r) * 1024 + 256 * g + 4 * lane) = acc[r] * sc;
}
__device__ __forceinline__ void hinit_row(const float* x, const float* meta, float* H, bf16* HB, float* ssq0, int row, int lane) {
    const float* src = row < MREAL ? x + (size_t)row * D_ : meta + (size_t)((row - MREAL) & 15) * D_;
    const f32x4* s4 = (const f32x4*)src + lane; f32x4* h4 = (f32x4*)(H + (size_t)row * D_) + lane;
    unsigned long long* b8 = (unsigned long long*)(HB + (size_t)row * D_) + lane;
    float ss = 0.f;
#pragma unroll
    for (int j = 0; j < 8; ++j) { const f32x4 v = s4[64 * j]; h4[64 * j] = v; ss += (v.x * v.x + v.y * v.y) + (v.z * v.z + v.w * v.w);
        b8[64 * j] = (unsigned long long)pk2(v.x, v.y) | ((unsigned long long)pk2(v.z, v.w) << 32); }
    ss = wave_sum(ss);
    if (lane < 8) ssq0[(size_t)lane * MROWS + row] = lane == 0 ? ss : 0.f;
}
__device__ __forceinline__ void conv_item(int kind, const float* W0, const float* W1, const float* T, const float* kgain, float aux, bf16* WT, int K, int nsrc, int item, int lane) {
    const int nkb = K >> 8, nb = item / nkb, kb = item - nb * nkb, c = nb * 64 + lane, k0 = kb * 256;
    const float* src; int pitch = nsrc;
    if (kind == 1) { const int pn = c >> 8, bj = (c >> 7) & 1, j = 128 * pn + (c & 127); src = (bj ? W1 : W0) + j; }
    else if (kind == 2) {
        if (c < 2048) { const int p = c & 63; const int d = 32 * ((p >> 2) & 1) + 16 * (p >> 5) + 4 * ((p >> 3) & 3) + (p & 3); src = W0 + (c & ~63) + d; }
        else if (c < 3072) src = W0 + c;
        else { src = T + (c - 3072); pitch = 1024; }
    } else src = W0 + c;
    src += (size_t)k0 * pitch;
    bf16* dst = WT + (size_t)c * K + k0;
#pragma unroll 1
    for (int kc = 0; kc < 8; ++kc) {
        float v[32];
#pragma unroll
        for (int e = 0; e < 32; ++e) v[e] = src[(size_t)(kc * 32 + e) * pitch];
#pragma unroll
        for (int e = 0; e < 32; ++e) { const int k = k0 + kc * 32 + e; float gk = 1.f;
            if (kind == 1 || kind == 2) gk = kgain[k]; else if (kind == 3) gk = k < 1024 ? kgain[k & 127] * aux : 1.f;
            v[e] *= gk; }
#pragma unroll
        for (int q = 0; q < 4; ++q) { v4u o; o.x = pk2(v[8 * q], v[8 * q + 1]); o.y = pk2(v[8 * q + 2], v[8 * q + 3]); o.z = pk2(v[8 * q + 4], v[8 * q + 5]); o.w = pk2(v[8 * q + 6], v[8 * q + 7]);
            *(v4u*)(dst + kc * 32 + 8 * q) = o; }
    }
}
__device__ __forceinline__ void cb_row(const bf16* O, const bf16* proj, bf16* cat, float lam, int row, int lane_in) {
    int lane = lane_in; asm volatile("" : "+v"(lane));
    if (row < MREAL) {
        const int h = lane >> 3, e0 = 16 * (lane & 7);
        const v4u* o1 = (const v4u*)(O + (size_t)row * D_ + (2 * h) * 128 + e0); const v4u* o2 = (const v4u*)(O + (size_t)row * D_ + (2 * h + 1) * 128 + e0);
        float d[16]; float ss = 0.f;
#pragma unroll
        for (int q = 0; q < 2; ++q) { const v4u a = o1[q], b = o2[q];
#pragma unroll
            for (int i = 0; i < 4; ++i) { d[8 * q + 2 * i] = bf_lo(a[i]) - lam * bf_lo(b[i]); d[8 * q + 2 * i + 1] = bf_hi(a[i]) - lam * bf_hi(b[i]); } }
#pragma unroll
        for (int i = 0; i < 16; ++i) ss += d[i] * d[i];
        ss += __shfl_xor(ss, 1); ss += __shfl_xor(ss, 2); ss += __shfl_xor(ss, 4);
        const float rn = 1.0f / sqrtf(ss * (1.0f / 128.0f) + SUBLN_EPS);
        v4u* op = (v4u*)(cat + (size_t)row * D_ + h * 128 + e0);
#pragma unroll
        for (int q = 0; q < 2; ++q) { v4u o; o.x = pk2(d[8 * q] * rn, d[8 * q + 1] * rn); o.y = pk2(d[8 * q + 2] * rn, d[8 * q + 3] * rn); o.z = pk2(d[8 * q + 4] * rn, d[8 * q + 5] * rn); o.w = pk2(d[8 * q + 6] * rn, d[8 * q + 7] * rn); op[q] = o; }
    }
    {
        int vrow, pos;
        if (row < MREAL) { const int b = row >> 11, t = row & 2047; vrow = b * VSEQ + 64 + t; pos = NMETA + t; } else { const int b = (row - MREAL) >> 4, j = (row - MREAL) & 15; vrow = b * VSEQ + 48 + j; pos = j; }
        const int w = 2 << (lane >> 4), cnt = (pos + 1) < w ? (pos + 1) : w;
        const bf16* zp = proj + (size_t)vrow * INW + 3072 + 16 * lane;
        float acc[16], self[16];
#pragma unroll
        for (int i = 0; i < 16; ++i) acc[i] = 0.f;
        for (int s = 0; s < cnt; ++s) { const v4u* z = (const v4u*)(zp - (size_t)s * INW);
#pragma unroll
            for (int q = 0; q < 2; ++q) { const v4u a = z[q];
#pragma unroll
                for (int i = 0; i < 4; ++i) { const float lo = bf_lo(a[i]), hi = bf_hi(a[i]); acc[8 * q + 2 * i] += lo; acc[8 * q + 2 * i + 1] += hi; if (s == 0) { self[8 * q + 2 * i] = lo; self[8 * q + 2 * i + 1] = hi; } } } }
        const float inv = 1.0f / (float)cnt;
        v4u* op = (v4u*)(cat + (size_t)row * D_ + 1024 + 16 * lane);
#pragma unroll
        for (int q = 0; q < 2; ++q) { float y[8];
#pragma unroll
            for (int i = 0; i < 8; ++i) y[i] = acc[8 * q + i] * inv - self[8 * q + i];
            v4u o; o.x = pk2(y[0], y[1]); o.y = pk2(y[2], y[3]); o.z = pk2(y[4], y[5]); o.w = pk2(y[6], y[7]); op[q] = o; }
    }
}
__device__ __forceinline__ void cb_meta_attn(const bf16* proj, bf16* cat, float lam, int b, int h, int lane_in) {
    int lane = lane_in; asm volatile("" : "+v"(lane));
    const int q = lane & 15, eg = lane >> 4; const bf16* base = proj + (size_t)(b * VSEQ + 48) * INW;
    float a[16];
#pragma unroll
    for (int k = 0; k < 16; ++k) a[k] = 0.f;
#pragma unroll 1
    for (int m = 0; m < 2; ++m) {
        const v4u* qp = (const v4u*)(base + (size_t)q * INW + (2 * h + m) * 64);
        float s[16]; float mx = -INFINITY;
#pragma unroll
        for (int k = 0; k < 16; ++k) { const v4u* kp = (const v4u*)(base + (size_t)k * INW + 1024 + (2 * h + m) * 64); float dsum = 0.f;
#pragma unroll
            for (int c = 0; c < 8; ++c) { const v4u w = kp[c], qw = qp[c];
#pragma unroll
                for (int i = 0; i < 4; ++i) dsum += bf_lo(qw[i]) * bf_lo(w[i]) + bf_hi(qw[i]) * bf_hi(w[i]); }
            s[k] = k <= q ? dsum : -INFINITY; mx = fmaxf(mx, s[k]); }
        float l = 0.f;
#pragma unroll
        for (int k = 0; k < 16; ++k) { s[k] = __builtin_amdgcn_exp2f(s[k] - mx); l += s[k]; }
        const float f = (m == 0 ? 1.0f : -lam) / l;
#pragma unroll
        for (int k = 0; k < 16; ++k) a[k] += f * s[k];
    }
    float o[32];
#pragma unroll
    for (int i = 0; i < 32; ++i) o[i] = 0.f;
#pragma unroll
    for (int k = 0; k < 16; ++k) { const v4u* vp = (const v4u*)(base + (size_t)k * INW + 2048 + h * 128 + 32 * eg);
#pragma unroll
        for (int c = 0; c < 4; ++c) { const v4u w = vp[c];
#pragma unroll
            for (int i = 0; i < 4; ++i) { o[8 * c + 2 * i] += a[k] * bf_lo(w[i]); o[8 * c + 2 * i + 1] += a[k] * bf_hi(w[i]); } } }
    float ss = 0.f;
#pragma unroll
    for (int i = 0; i < 32; ++i) ss += o[i] * o[i];
    ss += __shfl_xor(ss, 16); ss += __shfl_xor(ss, 32);
    const float rn = 1.0f / sqrtf(ss * (1.0f / 128.0f) + SUBLN_EPS);
    v4u* op = (v4u*)(cat + (size_t)(MREAL + 16 * b + q) * D_ + h * 128 + 32 * eg);
#pragma unroll
    for (int c = 0; c < 4; ++c) { v4u w; w.x = pk2(o[8 * c] * rn, o[8 * c + 1] * rn); w.y = pk2(o[8 * c + 2] * rn, o[8 * c + 3] * rn); w.z = pk2(o[8 * c + 4] * rn, o[8 * c + 5] * rn); w.w = pk2(o[8 * c + 6] * rn, o[8 * c + 7] * rn); op[c] = w; }
}
#ifndef MK_ONE_LAUNCH
#define MK_ONE_LAUNCH 0
#endif
typedef __attribute__((address_space(4))) const Args* KArgs;
__device__ __forceinline__ KArgs kargs() { KArgs p = (KArgs)__builtin_amdgcn_kernarg_segment_ptr(); asm volatile("" : "+s"(p)); return p; }
__global__ void __launch_bounds__(NWAVES * 64, 2) fwd_kernel(Args args_unused) {
    extern __shared__ __attribute__((aligned(16))) unsigned char lds[];
    Frame F;
    F.lds = (LAS unsigned char*)lds;
    F.MISC = (volatile LAS unsigned*)(F.lds + MISC_OFF);
    F.wave = __builtin_amdgcn_readfirstlane((int)threadIdx.x >> 6);
#define LANE() ({ int t_ = threadIdx.x; asm volatile("" : "+v"(t_)); t_ & 63; })
    F.G = gridDim.x; { const int bx = blockIdx.x; F.vcu = (F.G % 8 == 0) ? (bx % 8) * (F.G / 8) + bx / 8 : bx; }
    F.ctl = (gu32*)(kargs()->ws + WS_CTL);
    for (int u = threadIdx.x; u < (LDS_BYTES - LDSCTL_OFF) / 4; u += NWAVES * 64) ((LAS unsigned*)(F.lds + LDSCTL_OFF))[u] = 0u;
    __syncthreads();
    const int lo = kargs()->ph_lo, hi = kargs()->ph_hi;
    if (hi - lo > 1) (void)xcd_barrier_post((unsigned*)(F.ctl + CW_BAR), F.MISC + 8);
#ifndef PH_MASK
#define PH_MASK 0xFFFFFFFFu
#endif
#define EN(bit) ((PH_MASK >> (bit)) & 1u)
#define IN(k) (lo <= (k) && (k) < hi)
#define SEAM(k) do { if (IN(k) && IN((k) + 1)) { XcdBarrier bar_; bar_.bar = (unsigned*)(kargs()->ws + WS_CTL) + CW_BAR; bar_.x = xb_xcc_id(); bar_.st = F.MISC + 8; xcd_barrier(bar_); } } while (0)
#define WSP(T, off) ((T*)(A->ws + (off)))
    const int gw = F.vcu * NWAVES + F.wave, NGW = F.G * NWAVES;

    if (EN(0) && IN(0)) { const KArgs A = kargs(); const int lane = LANE(); float* TF = WSP(float, WS_TFOLD); float* RC = WSP(float, WS_ROPE); float* RS = RC + NPOS * 32;
        for (int it = gw; it < 4096; it += NGW) fold_item(A->in[7], A->in[13], A->in[14], TF, it, lane);
        for (int r = gw; r < MROWS; r += NGW) hinit_row(A->in[0], A->in[1], WSP(float, WS_H), WSP(bf16, WS_HB), WSP(float, WS_SSQ), r, lane);
        for (int i = gw * 64 + lane; i < NPOS * 32; i += NGW * 64) { const int pos = i >> 5, f = i & 31;
            const float inv = 1.0f / powf(10000.0f, (float)(2 * f) / 64.0f); const float ang = (float)pos * inv; RC[i] = cosf(ang); RS[i] = sinf(ang); }
    }
    SEAM(0);
    if (EN(1) && IN(1)) { const KArgs A = kargs(); const int lane = LANE(); unsigned char* ws = A->ws; float* TF = WSP(float, WS_TFOLD);
        constexpr int I_GU = (2 * FF_ / 64) * (D_ / 256), I_D = (D_ / 64) * (FF_ / 256), I_IN = (INW / 64) * (D_ / 256), I_OUT = (D_ / 64) * (D_ / 256), I_L = 2 * I_GU + 2 * I_D + I_IN + I_OUT;
        for (int it = gw; it < DEPTH * I_L; it += NGW) {
            const int L = it / I_L; int r = it - L * I_L; unsigned char* wl = ws + WS_WTS + (size_t)L * WL_BYTES;
            const size_t oFF = (size_t)L * D_ * FF_;
            if (r < I_GU) { conv_item(1, A->in[3] + oFF, A->in[4] + oFF, nullptr, A->in[2] + L * D_, 0.f, (bf16*)(wl + WL_GU1), D_, FF_, r, lane); continue; } r -= I_GU;
            if (r < I_D) { conv_item(0, A->in[5] + oFF, nullptr, nullptr, nullptr, 0.f, (bf16*)(wl + WL_D1), FF_, D_, r, lane); continue; } r -= I_D;
            if (r < I_IN) { conv_item(2, A->in[7] + (size_t)L * D_ * INW, nullptr, TF + (size_t)L * D_ * 1024, A->in[6] + L * D_, 0.f, (bf16*)(wl + WL_IN), D_, INW, r, lane); continue; } r -= I_IN;
            if (r < I_OUT) { conv_item(3, A->in[15] + (size_t)L * D_ * D_, nullptr, nullptr, A->in[12] + L * 128, 1.0f - A->lam_init[L], (bf16*)(wl + WL_OUT), D_, D_, r, lane); continue; } r -= I_OUT;
            if (r < I_GU) { conv_item(1, A->in[17] + oFF, A->in[18] + oFF, nullptr, A->in[16] + L * D_, 0.f, (bf16*)(wl + WL_GU2), D_, FF_, r, lane); continue; } r -= I_GU;
            conv_item(0, A->in[19] + oFF, nullptr, nullptr, nullptr, 0.f, (bf16*)(wl + WL_D2), FF_, D_, r, lane);
        }
    }
    SEAM(1);
#pragma unroll 1
    for (int Lc = 0; Lc < DEPTH; ++Lc) {
        const int pb = 2 + 8 * Lc;
#define LAYER() int L = Lc; asm volatile("" : "+s"(L))
#define WL(off) ((const bf16*)(A->ws + WS_WTS + (size_t)L * WL_BYTES + (off)))
#define SSQ(k) ((float*)(A->ws + WS_SSQ + (size_t)(3 * L + (k)) * SSQ_SET))
        if (EN(2) && IN(pb + 0)) { const KArgs A = kargs(); LAYER(); pg8::Gemm g{WSP(bf16, WS_HB), WL(WL_GU1), MROWS, 2 * FF_, D_}; pg8::StaticOrder S; S.init(MROWS, 2 * FF_, F.G, (int)blockIdx.x);
            pg8::EpiSwiGLU E{WSP(bf16, WS_MID), SSQ(0)}; pg8::gemm_phase<pg8::EpiSwiGLU, pg8::StaticOrder, true, true>(F.lds + RING_OFF, g, S, E); }
        SEAM(pb + 0);
        if (EN(3) && IN(pb + 1)) { const KArgs A = kargs(); LAYER(); pg8::Gemm g{WSP(bf16, WS_MID), WL(WL_D1), MROWS, D_, FF_}; pg8::StaticOrder S; S.init(MROWS, D_, F.G, (int)blockIdx.x);
            pg8::EpiResid E{WSP(float, WS_H), WSP(bf16, WS_HB), SSQ(1), 0.5f, F.lds + XR_OFF}; pg8::gemm_phase<pg8::EpiResid, pg8::StaticOrder, true, true>(F.lds + RING_OFF, g, S, E); }
        SEAM(pb + 1);
        if (EN(4) && IN(pb + 2)) { const KArgs A = kargs(); LAYER(); pg8::Gemm g{WSP(bf16, WS_HB), WL(WL_IN), MROWS, INW, D_}; pg8::StaticOrder S; S.init(MROWS, INW, F.G, (int)blockIdx.x);
            pg8::EpiProj E{WSP(bf16, WS_PROJ), SSQ(1), WSP(float, WS_ROPE), WSP(float, WS_ROPE) + NPOS * 32}; pg8::gemm_phase<pg8::EpiProj, pg8::StaticOrder, true, true>(F.lds + RING_OFF, g, S, E); }
        SEAM(pb + 2);
        if (EN(5) && IN(pb + 3)) { const KArgs A = kargs(); LAYER(); const bf16* PROJ = WSP(bf16, WS_PROJ); bf16* OB = (bf16*)A->out;
            for (int v = F.vcu; v < 256; v += F.G) { const int bh = v >> 1, sx = v & 1, b = bh >> 3, h = bh & 7;
#pragma unroll 1
                for (int i = 0; i < 16; ++i) { const int vhd = i >> 2, m = vhd >> 1, vh = vhd & 1, qs = i & 3;
                    const int qb = sx == 0 ? (qs == 0 ? 0 : qs == 1 ? 7 : qs == 2 ? 1 : 6) : (qs == 0 ? 2 : qs == 1 ? 5 : qs == 2 ? 3 : 4);
                    const attn_body::bf16* P = (const attn_body::bf16*)PROJ + (size_t)b * VSEQ * INW;
                    attn_body::attn_unit<8>(qb, P + (size_t)(64 + 256 * qb) * INW + (2 * h + m) * 64, P + 1024 + (2 * h + m) * 64, P + 2048 + h * 128 + vh * 64,
                                            (attn_body::bf16*)OB + (size_t)(b * NSEQ + 256 * qb) * D_ + (2 * h + m) * 128 + vh * 64, (char*)lds + RING_OFF); } }
        }
        SEAM(pb + 3);
        if (EN(6) && IN(pb + 4)) { const KArgs A = kargs(); LAYER(); const int lane = LANE(); const bf16* PROJ = WSP(bf16, WS_PROJ); bf16* OB = (bf16*)A->out; bf16* CAT = WSP(bf16, WS_CAT);
            const float sa = wave_sum(A->in[8][L * 64 + lane] * A->in[9][L * 64 + lane]), sb = wave_sum(A->in[10][L * 64 + lane] * A->in[11][L * 64 + lane]);
            const float lam = expf(sa) - expf(sb) + A->lam_init[L];
            for (int r = gw; r < MROWS; r += NGW) cb_row(OB, PROJ, CAT, lam, r, lane);
            for (int it = gw; it < NBATCH * NHEADS; it += NGW) cb_meta_attn(PROJ, CAT, lam, it >> 3, it & 7, lane);
        }
        SEAM(pb + 4);
        if (EN(7) && IN(pb + 5)) { const KArgs A = kargs(); LAYER(); pg8::Gemm g{WSP(bf16, WS_CAT), WL(WL_OUT), MROWS, D_, D_}; pg8::StaticOrder S; S.init(MROWS, D_, F.G, (int)blockIdx.x);
            pg8::EpiResid E{WSP(float, WS_H), WSP(bf16, WS_HB), SSQ(2), 1.0f, F.lds + XR_OFF}; pg8::gemm_phase<pg8::EpiResid, pg8::StaticOrder, true, true>(F.lds + RING_OFF, g, S, E); }
        SEAM(pb + 5);
        if (EN(8) && IN(pb + 6)) { const KArgs A = kargs(); LAYER(); pg8::Gemm g{WSP(bf16, WS_HB), WL(WL_GU2), MROWS, 2 * FF_, D_}; pg8::StaticOrder S; S.init(MROWS, 2 * FF_, F.G, (int)blockIdx.x);
            pg8::EpiSwiGLU E{WSP(bf16, WS_MID), SSQ(2)}; pg8::gemm_phase<pg8::EpiSwiGLU, pg8::StaticOrder, true, true>(F.lds + RING_OFF, g, S, E); }
        SEAM(pb + 6);
        if (EN(9) && IN(pb + 7)) { const KArgs A = kargs(); LAYER(); pg8::Gemm g{WSP(bf16, WS_MID), WL(WL_D2), MROWS, D_, FF_}; pg8::StaticOrder S; S.init(MROWS, D_, F.G, (int)blockIdx.x);
            pg8::EpiResid E{WSP(float, WS_H), WSP(bf16, WS_HB), SSQ(3), 0.5f, F.lds + XR_OFF}; pg8::gemm_phase<pg8::EpiResid, pg8::StaticOrder, true, true>(F.lds + RING_OFF, g, S, E); }
        SEAM(pb + 7);
    }
    if (EN(10) && IN(NPHASE - 1)) { const KArgs A = kargs(); const int lane = LANE(); const float* Hf = WSP(float, WS_H); float* outp = A->out;
        const float* ssq = (const float*)(A->ws + WS_SSQ + (size_t)12 * SSQ_SET); const float* gf = A->in[20];
        unsigned poison = 0u;
        if (hi - lo > 1) poison = __hip_atomic_load((gu32*)((gu32*)(A->ws + WS_CTL) + CW_BAR + XB_TMO), RLX_AGENT);
        for (int r = gw; r < MREAL; r += NGW) {
            float s = 0.f;
#pragma unroll
            for (int p = 0; p < 8; ++p) s += ssq[(size_t)p * MROWS + r];
            float rn = 1.0f / sqrtf(s * (1.0f / 2048.0f) + NORM_EPS); if (poison) rn = __builtin_nanf("");
            const f32x4* h4 = (const f32x4*)(Hf + (size_t)r * D_) + lane; const f32x4* g4 = (const f32x4*)gf + lane; f32x4* o4 = (f32x4*)(outp + (size_t)r * D_) + lane;
#pragma unroll
            for (int j = 0; j < 8; ++j) o4[64 * j] = h4[64 * j] * rn * g4[64 * j];
        }
    }
#undef IN
#undef SEAM
#undef LAYER
#undef LANE
#undef WSP
#undef WL
#undef SSQ
}

extern "C" void kernel_launch(void* const* d_in, const int* in_sizes, int n_in, void* d_out, int out_size, void* d_ws, size_t ws_size, hipStream_t stream) {
    static int grid = 0;
    if (grid == 0) {
        if (n_in != 21 || in_sizes[0] != MREAL * D_ || out_size != MREAL * D_ || ws_size < WS_END) { fprintf(stderr, "kernel_launch: unexpected shapes (n_in %d, in0 %d, out %d, ws %zu < %zu); nothing launched\n", n_in, n_in > 0 ? in_sizes[0] : -1, out_size, ws_size, (size_t)WS_END); grid = -1; return; }
        int dev = 0, cus = 0, per_cu = 0;
        if (hipGetDevice(&dev) != hipSuccess || hipDeviceGetAttribute(&cus, hipDeviceAttributeMultiprocessorCount, dev) != hipSuccess) { grid = -1; return; }
        if (hipFuncSetAttribute((const void*)fwd_kernel, hipFuncAttributeMaxDynamicSharedMemorySize, LDS_BYTES) != hipSuccess) { fprintf(stderr, "kernel_launch: hipFuncSetAttribute failed\n"); grid = -1; return; }
        if (hipOccupancyMaxActiveBlocksPerMultiprocessor(&per_cu, (const void*)fwd_kernel, NWAVES * 64, LDS_BYTES) != hipSuccess || per_cu < 1) { fprintf(stderr, "kernel_launch: occupancy query reports %d workgroups per CU\n", per_cu); }
        (void)hipGetLastError();
        grid = cus;
    }
    if (grid < 0) return;
    if (hipMemsetAsync((char*)d_ws + WS_CTL, 0, CTL_ZERO_BYTES, stream) != hipSuccess) { fprintf(stderr, "kernel_launch: memset failed\n"); return; }
    Args a{};
    for (int i = 0; i < 21; ++i) a.in[i] = (const float*)d_in[i];
    a.out = (float*)d_out; a.ws = (unsigned char*)d_ws;
    for (int L = 0; L < 4; ++L) a.lam_init[L] = (float)(0.8 - 0.6 * exp(-0.3 * (double)L));
#if MK_ONE_LAUNCH
    a.ph_lo = 0; a.ph_hi = NPHASE;
    hipLaunchKernelGGL(fwd_kernel, dim3(grid), dim3(NWAVES * 64), LDS_BYTES, stream, a);
#else
    for (int p = 0; p < NPHASE; ++p) { a.ph_lo = p; a.ph_hi = p + 1; hipLaunchKernelGGL(fwd_kernel, dim3(grid), dim3(NWAVES * 64), LDS_BYTES, stream, a); }
#endif
    const hipError_t le = hipPeekAtLastError();
    if (le != hipSuccess) fprintf(stderr, "kernel_launch: launch failed: %s\n", hipGetErrorName(le));
}
```

```cpp
#include <hip/hip_runtime.h>
#include <hip/hip_bf16.h>
#include <cstdio>
#include <cstdint>
#include <cmath>

constexpr int D_ = 2048, NBATCH = 16, NSEQ = 2048, DEPTH = 4, NMETA = 16, FF_ = 5632, INW = 4096, NHEADS = 8;
constexpr int MREAL = NBATCH * NSEQ;
constexpr int MROWS = MREAL + 256;
constexpr int VSEQ = 2112;
constexpr int VROWS = NBATCH * VSEQ;
constexpr int NPOS = NMETA + NSEQ;
constexpr float NORM_EPS = 1e-6f, SUBLN_EPS = 1e-5f;
constexpr int LDH = D_ + 128;
constexpr int LDM = FF_ + 128;
constexpr int LDP = INW + 128;
constexpr float QSCALE = 0.125f * 1.4426950408889634f;

namespace pg8 {
#define PG8_LAS __attribute__((address_space(3)))
typedef unsigned short bf16_t;
typedef short bf16x8 __attribute__((ext_vector_type(8)));
typedef float f32x4 __attribute__((ext_vector_type(4)));
typedef unsigned u32x4 __attribute__((ext_vector_type(4)));
constexpr int BM = 256, BK = 64, HALF = 128, HTB = HALF * BK * 2  , STAGE_BYTES = 8 * HTB, NXCD = 8;

__host__ __device__ __forceinline__ int lds_byte(int r, int c) { const int st = (r >> 4) * 2 + (c >> 5), rr = r & 15, cc = c & 31, ob = rr * 64 + cc * 2; return st * 1024 + (ob ^ (((ob >> 9) & 1) << 5)); }
__host__ __device__ __forceinline__ void stage_rc(int b, int& R, int& C) { const int st = b / 1024, sb = b % 1024, swz = sb ^ (((sb >> 9) & 1) << 5); R = (st >> 1) * 16 + swz / 64; C = (st & 1) * 32 + (swz % 64) / 2; }
__host__ __device__ __forceinline__ int perm32(int rho) { const int n = rho >> 4, i = rho & 15; return 8 * (i >> 2) + 4 * n + (i & 3); }

typedef _Float16 f16x8 __attribute__((ext_vector_type(8)));
template <bool F16> __device__ __forceinline__ f32x4 mma16(bf16x8 a, bf16x8 b, f32x4 c) {
    if constexpr (F16) return __builtin_amdgcn_mfma_f32_16x16x32_f16(__builtin_bit_cast(f16x8, a), __builtin_bit_cast(f16x8, b), c, 0, 0, 0);
    else return __builtin_amdgcn_mfma_f32_16x16x32_bf16(a, b, c, 0, 0, 0); }
typedef _Float16 f16x2 __attribute__((ext_vector_type(2)));
__device__ __forceinline__ unsigned pk_f16(float lo, float hi) { f16x2 v; v.x = (_Float16)lo; v.y = (_Float16)hi; return __builtin_bit_cast(unsigned, v); }
__device__ __forceinline__ float f16_lo(unsigned w) { return (float)__builtin_bit_cast(f16x2, w).x; }
__device__ __forceinline__ float f16_hi(unsigned w) { return (float)__builtin_bit_cast(f16x2, w).y; }
struct Unit { int pm, pn, k0, nk; };
struct Gemm { const bf16_t* A; const bf16_t* Bt; int M, N, K, lda, ldb; };

struct StaticOrder {
    int nM, nN, nwg, G, c, WGM;
    __host__ __device__ void init(int M, int N, int G_, int c_, int wgm = 8) { nM = M / BM; nN = N / BM; nwg = nM * nN; G = G_; c = c_; WGM = wgm; }
    __host__ __device__ bool next(int i, Unit& u) const {
        const long L = (long)i * G + c; if (L >= nwg) return false;
        int wgid = (int)L; { const int q = nwg / NXCD, r = nwg % NXCD, xcd = wgid % NXCD, off = wgid / NXCD; wgid = (xcd < r ? xcd * (q + 1) : r * (q + 1) + (xcd - r) * q) + off; }
        const int nig = WGM * nN, gid = wgid / nig, fm = gid * WGM, gsz = (nM - fm) < WGM ? (nM - fm) : WGM;
        u.pm = fm + ((wgid % nig) % gsz); u.pn = (wgid % nig) / gsz; u.k0 = 0; u.nk = 0; return true;
    }
    __device__ __forceinline__ void a_ready(const Unit&) const {}
    __device__ __forceinline__ void done(const Unit&) const {}
};

__device__ __forceinline__ unsigned cvt_pk_bf16(float lo, float hi) { unsigned r; asm volatile("v_cvt_pk_bf16_f32 %0, %1, %2" : "=v"(r) : "v"(lo), "v"(hi)); return r; }
typedef float f32x2 __attribute__((ext_vector_type(2)));
__device__ __forceinline__ float row_rstd(const float* ssq, int row) {
    float s = 0.f;
#pragma unroll
    for (int p = 0; p < 8; ++p) s += ssq[(size_t)p * MROWS + row];
    return __builtin_amdgcn_rsqf(s * (1.0f / 2048.0f) + NORM_EPS);
}
__device__ __forceinline__ void row_scales(float (&rs)[2][4], const float* ssq, int pm, int wr, int fr, int fq) {
    const int lane = fq * 16 + fr; float r2[2];
#pragma unroll
    for (int k = 0; k < 2; ++k) r2[k] = row_rstd(ssq, pm * BM + 128 * k + 64 * wr + lane);
#pragma unroll
    for (int ai = 0; ai < 2; ++ai)
#pragma unroll
        for (int m = 0; m < 4; ++m) rs[ai][m] = __shfl(r2[ai], m * 16 + fr);
}
template <int PM = 0> struct EpiSwiGLUT {
    static constexpr bool PERM = true, AFTER_DRAIN = false;
    bf16_t* O; const float* ssq;
    __device__ __forceinline__ void operator()(const f32x4 (&acc)[2][2][4][2], const Unit& u, int wr, int wc, int fr_, int fq_) const {
        int fr = fr_, fq = fq_; asm volatile("" : "+v"(fr), "+v"(fq));
        const int row0 = u.pm * BM + wr * 64 + fr, col0 = u.pn * HALF + wc * 32 + 8 * fq;
        float rs[2][4]; if (PM == 6) { for (int a = 0; a < 2; ++a) for (int b = 0; b < 4; ++b) rs[a][b] = 1.0f; } else row_scales(rs, ssq, u.pm, wr, fr, fq);
#pragma unroll
        for (int ai = 0; ai < 2; ++ai)
#pragma unroll
            for (int m = 0; m < 4; ++m) { const float r = rs[ai][m]; f32x4 o[2];
#pragma unroll
                for (int n = 0; n < 2; ++n) { const f32x4 g = acc[ai][0][m][n] * r, up = acc[ai][1][m][n] * r, t = g * -1.4426950408889634f; f32x4 e;
#pragma unroll
                    for (int i = 0; i < 4; ++i) e[i] = PM == 8 ? t[i] : __builtin_amdgcn_rcpf(1.0f + __builtin_amdgcn_exp2f(t[i]));
                    o[n] = (g * up) * e; }
                u32x4 w; w.x = cvt_pk_bf16(o[0][0], o[0][1]); w.y = cvt_pk_bf16(o[0][2], o[0][3]); w.z = cvt_pk_bf16(o[1][0], o[1][1]); w.w = cvt_pk_bf16(o[1][2], o[1][3]);
                if (PM == 0) *(u32x4*)(O + (size_t)(row0 + ai * HALF + m * 16) * LDM + col0) = w; else if (w.x == 0x12345678u) O[0] = 1; }
    }
};
typedef EpiSwiGLUT<0> EpiSwiGLU;
template <int PM = 0> struct EpiResidT {
    static constexpr bool PERM = true, AFTER_DRAIN = false;
    bf16_t* HB; float* ssq_out; float scale; PG8_LAS unsigned char* xr; bf16_t* dummy; bf16_t* H16;
    __device__ __forceinline__ void operator()(const f32x4 (&acc)[2][2][4][2], const Unit& u, int wr, int wc, int fr_, int fq_) const {
        int fr = fr_, fq = fq_; asm volatile("" : "+v"(fr), "+v"(fq));
        const int row0 = u.pm * BM + wr * 64 + fr, col0 = u.pn * BM + wc * 32 + 8 * fq;
        PG8_LAS float* XS = (PG8_LAS float*)xr + (wr * 4 + wc) * 128;
#pragma unroll
        for (int ai = 0; ai < 2; ++ai) {
            u32x4 old[4][2];
#pragma unroll
            for (int m = 0; m < 4; ++m)
#pragma unroll
                for (int bj = 0; bj < 2; ++bj) { if (PM == 4 || PM == 5) old[m][bj] = (u32x4){0u, 0u, 0u, 0u}; else old[m][bj] = *(const u32x4*)((H16 ? H16 : HB) + (size_t)(row0 + ai * HALF + m * 16) * LDH + col0 + bj * HALF); }
#pragma unroll
            for (int m = 0; m < 4; ++m) { bf16_t* bp = (PM == 4 ? dummy : HB) + (size_t)(row0 + ai * HALF + m * 16) * LDH + col0; f32x4 sq = (f32x4){0.f, 0.f, 0.f, 0.f};
#pragma unroll
                for (int bj = 0; bj < 2; ++bj) { const u32x4 o = old[m][bj];
                    f32x4 h0 = (f32x4){f16_lo(o.x), f16_hi(o.x), f16_lo(o.y), f16_hi(o.y)}, h1 = (f32x4){f16_lo(o.z), f16_hi(o.z), f16_lo(o.w), f16_hi(o.w)};
                    h0 = h0 + acc[ai][bj][m][0] * scale; h1 = h1 + acc[ai][bj][m][1] * scale;
                    u32x4 w; w.x = pk_f16(h0[0], h0[1]); w.y = pk_f16(h0[2], h0[3]); w.z = pk_f16(h1[0], h1[1]); w.w = pk_f16(h1[2], h1[3]);
                    if (PM == 0 || PM == 4) { if (H16) { *(u32x4*)(H16 + (size_t)(row0 + ai * HALF + m * 16) * LDH + col0 + bj * HALF) = w; u32x4 wb; wb.x = cvt_pk_bf16(h0[0], h0[1]); wb.y = cvt_pk_bf16(h0[2], h0[3]); wb.z = cvt_pk_bf16(h1[0], h1[1]); wb.w = cvt_pk_bf16(h1[2], h1[3]); *(u32x4*)(bp + bj * HALF) = wb; } else *(u32x4*)(bp + bj * HALF) = w; }
                    sq = sq + h0 * h0 + h1 * h1; }
                float s = (sq[0] + sq[1]) + (sq[2] + sq[3]);
                s += __shfl_xor(s, 16); s += __shfl_xor(s, 32);
                if (fq == 0) XS[ai * 64 + m * 16 + fr] = s; }
            asm volatile("" ::: "memory"); }
        asm volatile("s_waitcnt lgkmcnt(0)" ::: "memory");
        PG8_LAS unsigned* cnt = (PG8_LAS unsigned*)(xr + 4096) + wr;
        unsigned old_c = 0u; const int lane = fq * 16 + fr;
        if (lane == 0) old_c = __hip_atomic_fetch_add(cnt, 1u, __ATOMIC_RELAXED, __HIP_MEMORY_SCOPE_WORKGROUP);
        old_c = (unsigned)__builtin_amdgcn_readfirstlane((int)old_c);
        asm volatile("" ::: "memory");
        if ((old_c & 3u) == 3u) {
            const PG8_LAS float* X0 = (const PG8_LAS float*)xr + (wr * 4) * 128;
#pragma unroll
            for (int k = 0; k < 2; ++k) { const int q = lane + 64 * k; const float t = ((X0[q] + X0[128 + q]) + X0[256 + q]) + X0[384 + q];
                if (PM == 0) ssq_out[(size_t)u.pn * MROWS + u.pm * BM + 128 * k + 64 * wr + lane] = t; else if (t == 1.2345e30f) ssq_out[0] = t; }
            asm volatile("s_waitcnt lgkmcnt(0)" ::: "memory");
        }
    }
};
typedef EpiResidT<0> EpiResid;
struct EpiProj {
    static constexpr bool PERM = true, AFTER_DRAIN = false;
    bf16_t* P; const float* ssq; const float* rcos; const float* rsin;
    __device__ __forceinline__ void operator()(const f32x4 (&acc)[2][2][4][2], const Unit& u, int wr, int wc, int fr_, int fq_) const {
        int fr = fr_, fq = fq_; asm volatile("" : "+v"(fr), "+v"(fq));
        const int rt0 = wr * 64 + fr, pn = u.pn;
        float rs[2][4]; row_scales(rs, ssq, u.pm, wr, fr, fq);
#pragma unroll
        for (int ai = 0; ai < 2; ++ai)
#pragma unroll
            for (int m = 0; m < 4; ++m) { const int rt = rt0 + ai * HALF + m * 16; float r = rs[ai][m];
                int vrow, pos;
                if (u.pm < MREAL / BM) { const int b = u.pm >> 3, t = (u.pm & 7) * BM + rt; vrow = b * VSEQ + 64 + t; pos = NMETA + t; }
                else { const int b = rt >> 4, j = rt & 15; vrow = b * VSEQ + 48 + j; pos = j; }
                bf16_t* op = P + (size_t)vrow * LDP + pn * BM;
                if (pn < 8) {
                    if (pn < 4) r *= QSCALE;
                    const int f0 = 16 * (wc & 1) + 4 * fq;
                    const f32x4 c = *(const f32x4*)(rcos + pos * 32 + f0), s = *(const f32x4*)(rsin + pos * 32 + f0);
#pragma unroll
                    for (int bj = 0; bj < 2; ++bj) { const f32x4 xl = acc[ai][bj][m][0] * r, xh = acc[ai][bj][m][1] * r;
                        const f32x4 ol = xl * c - xh * s, oh = xh * c + xl * s;
                        typedef unsigned u32x2v __attribute__((ext_vector_type(2)));
                        u32x2v wl, wh; wl.x = cvt_pk_bf16(ol[0], ol[1]); wl.y = cvt_pk_bf16(ol[2], ol[3]); wh.x = cvt_pk_bf16(oh[0], oh[1]); wh.y = cvt_pk_bf16(oh[2], oh[3]);
                        bf16_t* hp = op + 64 * (2 * bj + (wc >> 1)) + f0;
                        *(u32x2v*)hp = wl; *(u32x2v*)(hp + 32) = wh; }
                } else {
#pragma unroll
                    for (int bj = 0; bj < 2; ++bj) { const f32x4 v0 = acc[ai][bj][m][0] * r, v1 = acc[ai][bj][m][1] * r;
                        u32x4 w; w.x = cvt_pk_bf16(v0[0], v0[1]); w.y = cvt_pk_bf16(v0[2], v0[3]); w.z = cvt_pk_bf16(v1[0], v1[1]); w.w = cvt_pk_bf16(v1[2], v1[3]);
                        *(u32x4*)(op + bj * HALF + wc * 32 + 8 * fq) = w; }
                }
                asm volatile("" ::: "memory");
            }
    }
};

struct StaggerOrder : StaticOrder {
    int j, ntf, nu;
    __device__ void init2(int M, int N, int K, int G_, int c_, int j_, int wgm = 8) { init(M, N, G_, c_, wgm); j = j_; ntf = K / BK; nu = (nwg - c_ + G_ - 1) / G_; if (nu < 2) j = 0; }
    __device__ bool next(int i, Unit& u) const {
        if (j == 0) return StaticOrder::next(i, u);
        if (i > nu) return false;
        const int n1 = (ntf * j / 4) & ~1;
        if (i == 0) { StaticOrder::next(0, u); u.k0 = n1; u.nk = ntf - n1; return true; }
        if (i == nu) { StaticOrder::next(0, u); u.k0 = 0; u.nk = n1; return true; }
        return StaticOrder::next(i, u);
    }
};
template <class Epi, class Sched, bool ALIGN_EPI = false, bool SP2 = false, bool F16 = false  >
__device__ __forceinline__ void gemm_phase(PG8_LAS unsigned char* lds, const Gemm g, const Sched& S, const Epi& E) {
    int tid_ = threadIdx.x; asm volatile("" : "+v"(tid_));
    const int tid = tid_, wid = __builtin_amdgcn_readfirstlane(tid >> 6), lane = tid & 63, wr = wid >> 2, wc = wid & 3, fr = lane & 15, fq = lane >> 4;
    const int K = g.K, nt = K / BK;
    unsigned voffA[2], voffB[2];
#pragma unroll
    for (int i = 0; i < 2; ++i) { int R, C; stage_rc(tid * 16 + i * 8192, R, C); const int Rb = Epi::PERM ? ((R & ~31) + perm32(R & 31)) : R;
        voffA[i] = (unsigned)(R * g.lda + C) * 2u; voffB[i] = (unsigned)(Rb * g.ldb + C) * 2u; }
    const size_t kstep = (size_t)(BK * 2);
    const size_t hstepA = (size_t)HALF * g.lda * 2, hstepB = (size_t)HALF * g.ldb * 2;
    const size_t tstepA = 2 * hstepA, tstepB = 2 * hstepB;
    const unsigned ldsw = (unsigned)wid * 1024u;
    const int aoff = lds_byte(wr * 64 + fr, fq * 8), boff = lds_byte(wc * 32 + fr, fq * 8);
#define PG8_SA(b, h) (((b) * 2 + (h)) * HTB)
#define PG8_SB(b, h) ((4 + (b) * 2 + (h)) * HTB)
#define PG8_STAGE(bufoff, gbase, voff) do { _Pragma("unroll") for (int _i = 0; _i < 2; ++_i) \
        __builtin_amdgcn_global_load_lds((const unsigned*)((const char*)(gbase) + (voff)[_i]), (PG8_LAS unsigned*)(lds + (bufoff) + ldsw + _i * 8192), 16, 0, 0); } while (0)
#define PG8_LDA(dst, b, h) do { _Pragma("unroll") for (int m = 0; m < 4; ++m) _Pragma("unroll") for (int k = 0; k < 2; ++k) dst[m][k] = *(const PG8_LAS bf16x8*)(lds + PG8_SA(b, h) + aoff + m * 2048 + k * 1024); } while (0)
#define PG8_LDB(dst, b, h) do { _Pragma("unroll") for (int n = 0; n < 2; ++n) _Pragma("unroll") for (int k = 0; k < 2; ++k) dst[n][k] = *(const PG8_LAS bf16x8*)(lds + PG8_SB(b, h) + boff + n * 2048 + k * 1024); } while (0)
#define PG8_MMA(ai, bj, At, Bt) do { __builtin_amdgcn_s_setprio(1); _Pragma("unroll") for (int m = 0; m < 4; ++m) _Pragma("unroll") for (int n = 0; n < 2; ++n) _Pragma("unroll") for (int k = 0; k < 2; ++k) \
        acc[ai][bj][m][n] = mma16<F16>(Bt[n][k], At[m][k], acc[ai][bj][m][n]); __builtin_amdgcn_s_setprio(0); } while (0)
#define PG8_WAIT_V(n) asm volatile("s_waitcnt vmcnt(" #n ")" ::: "memory")
#define PG8_WAIT_L(n) asm volatile("s_waitcnt lgkmcnt(" #n ")" ::: "memory")
#define PG8_BAR __builtin_amdgcn_s_barrier()
#define PG8_SCHED __builtin_amdgcn_sched_barrier(0)
    Unit cur, nxt; int ui = 0;
    if (!S.next(0, cur)) return;
    f32x4 acc[2][2][4][2];
#pragma unroll
    for (int a = 0; a < 2; ++a)
#pragma unroll
        for (int b = 0; b < 2; ++b)
#pragma unroll
            for (int m = 0; m < 4; ++m)
#pragma unroll
                for (int n = 0; n < 2; ++n) acc[a][b][m][n] = (f32x4){0.f, 0.f, 0.f, 0.f};
    bf16x8 At[4][2], B0[2][2], B1[2][2];
    const char* cA = (const char*)g.A + (size_t)cur.pm * tstepA + (size_t)cur.k0 * kstep; const char* cB = (const char*)g.Bt + (size_t)cur.pn * tstepB + (size_t)cur.k0 * kstep;
    S.a_ready(cur);
    if constexpr (SP2) {
        PG8_STAGE(PG8_SB(0, 0), cB, voffB); PG8_STAGE(PG8_SB(0, 1), cB + hstepB, voffB); PG8_STAGE(PG8_SA(0, 0), cA, voffA); PG8_STAGE(PG8_SA(0, 1), cA + hstepA, voffA);
        if (wr == 1) PG8_BAR;
        PG8_WAIT_V(2); PG8_BAR;
        PG8_STAGE(PG8_SB(1, 0), cB + kstep, voffB); PG8_STAGE(PG8_SA(1, 0), cA + kstep, voffA); PG8_STAGE(PG8_SB(1, 1), cB + hstepB + kstep, voffB);
        PG8_WAIT_V(6); PG8_BAR;
    } else {
        PG8_STAGE(PG8_SB(0, 0), cB, voffB); PG8_STAGE(PG8_SA(0, 0), cA, voffA); PG8_STAGE(PG8_SB(0, 1), cB + hstepB, voffB); PG8_STAGE(PG8_SA(0, 1), cA + hstepA, voffA);
        if (wr == 1) PG8_BAR;
        PG8_WAIT_V(4); PG8_BAR;
        PG8_STAGE(PG8_SB(1, 0), cB + kstep, voffB); PG8_STAGE(PG8_SA(1, 0), cA + kstep, voffA); PG8_STAGE(PG8_SB(1, 1), cB + hstepB + kstep, voffB);
        PG8_WAIT_V(6); PG8_BAR;
    }
    for (;;) {
        const bool has_next = S.next(ui + 1, nxt);
        const char* nA = has_next ? (const char*)g.A + (size_t)nxt.pm * tstepA + (size_t)nxt.k0 * kstep : cA; const char* nB = has_next ? (const char*)g.Bt + (size_t)nxt.pn * tstepB + (size_t)nxt.k0 * kstep : cB;
        const int unt = cur.nk ? cur.nk : nt;
        for (int t = 0; t < unt; t += 2) {
            const bool last = (t == unt - 2);
            const char* a1 = cA + (size_t)(t + 1) * kstep;
            const char* a2 = last ? nA : cA + (size_t)(t + 2) * kstep; const char* b2 = last ? nB : cB + (size_t)(t + 2) * kstep;
            const char* a3 = a2 + kstep; const char* b3 = b2 + kstep;
            if (last && has_next) S.a_ready(nxt);
            if constexpr (SP2) {
            PG8_LDB(B0, 0, 0); PG8_LDB(B1, 0, 1); PG8_SCHED; PG8_LDA(At, 0, 0); PG8_STAGE(PG8_SA(1, 1), a1 + hstepA, voffA);
            PG8_WAIT_V(8); PG8_WAIT_L(0); PG8_BAR; PG8_MMA(0, 0, At, B0); PG8_MMA(0, 1, At, B1); PG8_BAR; PG8_SCHED;
            PG8_LDA(At, 0, 1); PG8_STAGE(PG8_SB(0, 0), b2, voffB); PG8_STAGE(PG8_SB(0, 1), b2 + hstepB, voffB); PG8_STAGE(PG8_SA(0, 0), a2, voffA);
            PG8_WAIT_V(8); PG8_WAIT_L(0); PG8_BAR; PG8_MMA(1, 0, At, B0); PG8_MMA(1, 1, At, B1); PG8_BAR; PG8_SCHED;
            PG8_LDB(B0, 1, 0); PG8_LDB(B1, 1, 1); PG8_SCHED; PG8_LDA(At, 1, 0); PG8_STAGE(PG8_SA(0, 1), a2 + hstepA, voffA);
            PG8_WAIT_V(8); PG8_WAIT_L(0); PG8_BAR; PG8_MMA(0, 0, At, B0); PG8_MMA(0, 1, At, B1); PG8_BAR; PG8_SCHED;
            PG8_LDA(At, 1, 1); PG8_STAGE(PG8_SB(1, 0), b3, voffB); PG8_STAGE(PG8_SB(1, 1), b3 + hstepB, voffB); PG8_STAGE(PG8_SA(1, 0), a3, voffA);
            PG8_WAIT_V(8); PG8_WAIT_L(0); PG8_BAR; PG8_MMA(1, 0, At, B0); PG8_MMA(1, 1, At, B1); PG8_BAR; PG8_SCHED;
            } else {
            PG8_LDB(B0, 0, 0); PG8_SCHED; PG8_LDA(At, 0, 0); PG8_STAGE(PG8_SA(1, 1), a1 + hstepA, voffA);
            PG8_WAIT_L(8); PG8_BAR; PG8_WAIT_L(0); PG8_MMA(0, 0, At, B0); PG8_BAR; PG8_SCHED;
            PG8_LDB(B1, 0, 1); PG8_STAGE(PG8_SB(0, 0), b2, voffB);
            PG8_BAR; PG8_WAIT_L(0); PG8_MMA(0, 1, At, B1); PG8_BAR;
            PG8_LDA(At, 0, 1); PG8_STAGE(PG8_SA(0, 0), a2, voffA);
            PG8_BAR; PG8_WAIT_L(0); PG8_MMA(1, 0, At, B0); PG8_BAR; PG8_SCHED;
            PG8_STAGE(PG8_SB(0, 1), b2 + hstepB, voffB);
            PG8_WAIT_V(6); PG8_BAR; PG8_MMA(1, 1, At, B1); PG8_BAR;
            PG8_LDB(B0, 1, 0); PG8_SCHED; PG8_LDA(At, 1, 0); PG8_STAGE(PG8_SA(0, 1), a2 + hstepA, voffA);
            PG8_WAIT_L(8); PG8_BAR; PG8_WAIT_L(0); PG8_MMA(0, 0, At, B0); PG8_BAR; PG8_SCHED;
            PG8_LDB(B1, 1, 1); PG8_STAGE(PG8_SB(1, 0), b3, voffB);
            PG8_BAR; PG8_WAIT_L(0); PG8_MMA(0, 1, At, B1); PG8_BAR;
            PG8_LDA(At, 1, 1); PG8_STAGE(PG8_SA(1, 0), a3, voffA);
            PG8_BAR; PG8_WAIT_L(0); PG8_MMA(1, 0, At, B0); PG8_BAR; PG8_SCHED;
            PG8_STAGE(PG8_SB(1, 1), b3 + hstepB, voffB);
            PG8_WAIT_V(6); PG8_BAR; PG8_MMA(1, 1, At, B1); PG8_BAR;
            }
        }
        if constexpr (ALIGN_EPI) { if (wr == 0) PG8_BAR; }
        if constexpr (!Epi::AFTER_DRAIN) { E(acc, cur, wr, wc, fr, fq); S.done(cur); }
        if (!has_next) break;
#pragma unroll
        for (int a = 0; a < 2; ++a)
#pragma unroll
            for (int b = 0; b < 2; ++b)
#pragma unroll
                for (int m = 0; m < 4; ++m)
#pragma unroll
                    for (int n = 0; n < 2; ++n) acc[a][b][m][n] = (f32x4){0.f, 0.f, 0.f, 0.f};
        cur = nxt; cA = nA; cB = nB; ++ui;
        if constexpr (ALIGN_EPI) { if (wr == 1) PG8_BAR; }
    }
    PG8_WAIT_V(0);
    if constexpr (!ALIGN_EPI) { if (wr == 0) PG8_BAR; }
    PG8_BAR;
    if constexpr (Epi::AFTER_DRAIN) { E.fused(acc, cur, wr, wc, fr, fq, lds, wid, lane); S.done(cur); }
#undef PG8_SA
#undef PG8_SB
#undef PG8_STAGE
#undef PG8_LDA
#undef PG8_LDB
#undef PG8_MMA
#undef PG8_WAIT_V
#undef PG8_WAIT_L
#undef PG8_BAR
#undef PG8_SCHED
}
}

namespace attn_body {
using bf16=__hip_bfloat16;
using bf16x8=__attribute__((ext_vector_type(8)))short;
using s16x4=__attribute__((ext_vector_type(4)))short;
using f32x16=__attribute__((ext_vector_type(16)))float;
using u32x4=__attribute__((ext_vector_type(4)))unsigned;
using f32x4=__attribute__((ext_vector_type(4)))float;
constexpr int D=64,QP=LDP,OP=LDH;
constexpr int NW=8,QBLK=32,QB=QBLK*NW,KVBLK=64;
constexpr int ATTN_UNIT_ROWS=QB;
__device__ __forceinline__ int crow(int r,int hi){return (r&3)+8*(r>>2)+4*hi;}
#define SBAR() __builtin_amdgcn_sched_barrier(0)
__device__ __forceinline__ void cmask(f32x16&p0,f32x16&p1,int jb,int qrel,int hi){
  const float NEG=-INFINITY; int kb=64*jb+4*hi;
  #pragma unroll
  for(int r=0;r<16;++r){int kv=kb+(r&3)+8*(r>>2); if(kv>qrel)p0[r]=NEG; if(kv+32>qrel)p1[r]=NEG;}
}

constexpr int NSLOT=3, SLOTB=8192;
constexpr int VSLOTB=2*SLOTB;
constexpr int LDS_K=0, LDS_V=NSLOT*SLOTB, LDS_WS=LDS_V+NSLOT*VSLOTB, LDS_OST=LDS_WS+NW*64*4, LDS_BYTES=LDS_OST+NW*4096;
constexpr float C2=0.125f*1.4426950408889634f;
__device__ __forceinline__ void glds16(const void*gsrc,unsigned lds_dst){unsigned keep;
  asm volatile("s_mov_b32 %0, m0\n\ts_mov_b32 m0, %2\n\ts_nop 0\n\tglobal_load_lds_dwordx4 %1, off\n\ts_mov_b32 m0, %0":"=&s"(keep):"v"(gsrc),"s"(lds_dst):"memory");}
__device__ __forceinline__ float max3f(float a,float b,float c){float r;asm("v_max3_f32 %0, %1, %2, %3":"=v"(r):"v"(a),"v"(b),"v"(c));return r;}
__device__ __forceinline__ float max2f(float a,float b){float r;asm("v_max_f32_e32 %0, %1, %2":"=v"(r):"v"(a),"v"(b));return r;}
__device__ __forceinline__ float fadd_s(float a,float b){float r;asm("v_add_f32_e32 %0, %1, %2":"=v"(r):"v"(a),"v"(b));return r;}
__device__ __forceinline__ float fsub_s(float a,float b){float r;asm("v_sub_f32_e32 %0, %1, %2":"=v"(r):"v"(a),"v"(b));return r;}
typedef float f32x2_t __attribute__((ext_vector_type(2))); typedef __bf16 bf16x2_t __attribute__((ext_vector_type(2)));
__device__ __forceinline__ unsigned cvtpk_s(float lo,float hi){f32x2_t v={lo,hi};bf16x2_t b=__builtin_convertvector(v,bf16x2_t);return __builtin_bit_cast(unsigned,b);}
#define WAIT_BAR(N) asm volatile("s_waitcnt vmcnt(" #N ") lgkmcnt(0)\n\ts_barrier":::"memory")

__device__ __forceinline__ void qkt(f32x16&p0,f32x16&p1,const char*Kslot,const bf16x8*qr,const f32x16&negm,int r32,int hi){
  const char*kb=Kslot+hi*1024+r32*16;
  #pragma unroll
  for(int d0=0;d0<4;++d0){
    const bf16x8 b0=*reinterpret_cast<const bf16x8*>(kb+d0*2048);
    const bf16x8 b1=*reinterpret_cast<const bf16x8*>(kb+d0*2048+512);
    if(d0==0){p0=__builtin_amdgcn_mfma_f32_32x32x16_bf16(b0,qr[0],negm,0,0,0);p1=__builtin_amdgcn_mfma_f32_32x32x16_bf16(b1,qr[0],negm,0,0,0);}
    else{p0=__builtin_amdgcn_mfma_f32_32x32x16_bf16(b0,qr[d0],p0,0,0,0);p1=__builtin_amdgcn_mfma_f32_32x32x16_bf16(b1,qr[d0],p1,0,0,0);}}
}
typedef __attribute__((address_space(3))) const char* lds_cptr;
typedef short v4i16_t __attribute__((ext_vector_type(4)));
__device__ __forceinline__ void kload8(bf16x8*kf,lds_cptr kp){
  kf[0]=*(const __attribute__((address_space(3))) bf16x8*)(kp);      kf[1]=*(const __attribute__((address_space(3))) bf16x8*)(kp+512);
  kf[2]=*(const __attribute__((address_space(3))) bf16x8*)(kp+2048); kf[3]=*(const __attribute__((address_space(3))) bf16x8*)(kp+2560);
  kf[4]=*(const __attribute__((address_space(3))) bf16x8*)(kp+4096); kf[5]=*(const __attribute__((address_space(3))) bf16x8*)(kp+4608);
  kf[6]=*(const __attribute__((address_space(3))) bf16x8*)(kp+6144); kf[7]=*(const __attribute__((address_space(3))) bf16x8*)(kp+6656);
}
__device__ __forceinline__ void kload2(bf16x8*kf,lds_cptr kp,int j){ kf[2*j]=*(const __attribute__((address_space(3))) bf16x8*)(kp+j*2048); kf[2*j+1]=*(const __attribute__((address_space(3))) bf16x8*)(kp+j*2048+512); }
__device__ __forceinline__ s16x4 vtr(lds_cptr p){ return __builtin_bit_cast(s16x4,__builtin_amdgcn_ds_read_tr16_b64_v4i16((__attribute__((address_space(3))) v4i16_t*)p)); }
__device__ __forceinline__ float rowmax(const f32x16&p0,const f32x16&p1){
  float a=max3f(p0[0],p0[1],p1[0]),b=max3f(p0[2],p0[3],p1[1]);a=max3f(a,p1[2],p1[3]);
  #pragma unroll
  for(int r=4;r<16;r+=4){a=max3f(a,p0[r],p0[r+1]);b=max3f(b,p0[r+2],p0[r+3]);a=max3f(a,p1[r],p1[r+1]);b=max3f(b,p1[r+2],p1[r+3]);}
  const float m=max2f(a,b);
  auto rr=__builtin_amdgcn_permlane32_swap(__float_as_uint(m),__float_as_uint(m),false,false);
  return max2f(__uint_as_float(rr[0]),__uint_as_float(rr[1]));
}
__device__ __forceinline__ void pv(f32x16*o,int vb,bf16x8 pa0,bf16x8 pa1,bf16x8 pa2,bf16x8 pa3){
  #pragma unroll
  for(int d0=0;d0<4;++d0){s16x4 lo[4],hi[4];
    #pragma unroll
    for(int ks=0;ks<4;++ks){
      asm volatile("ds_read_b64_tr_b16 %0,%1 offset:%c2":"=&v"(lo[ks]):"v"(vb),"i"(d0*4096+ks*1024):"memory");
      asm volatile("ds_read_b64_tr_b16 %0,%1 offset:%c2":"=&v"(hi[ks]):"v"(vb),"i"(d0*4096+ks*1024+512):"memory");}
    asm volatile("s_waitcnt lgkmcnt(0)":::"memory");SBAR();
    #define PK(k) (bf16x8){lo[k][0],lo[k][1],lo[k][2],lo[k][3],hi[k][0],hi[k][1],hi[k][2],hi[k][3]}
    o[d0]=__builtin_amdgcn_mfma_f32_32x32x16_bf16(pa0,PK(0),o[d0],0,0,0);
    o[d0]=__builtin_amdgcn_mfma_f32_32x32x16_bf16(pa1,PK(1),o[d0],0,0,0);
    o[d0]=__builtin_amdgcn_mfma_f32_32x32x16_bf16(pa2,PK(2),o[d0],0,0,0);
    o[d0]=__builtin_amdgcn_mfma_f32_32x32x16_bf16(pa3,PK(3),o[d0],0,0,0);
    #undef PK
  }
}

#ifndef ATTN_STORE16
#define ATTN_STORE16(p,v) (*(u32x4*)(p)=(v))
#endif
template<int THRL> __device__ __forceinline__ void attn_unit(int qb,const bf16*Q0,const bf16*__restrict__ Kh,const bf16*__restrict__ Vh,bf16*O0,char*shm,int mode,float lam,float*oscr){
  int tid_=threadIdx.x; asm volatile("":"+v"(tid_));
  const int tid=tid_,lane=tid&63,r32=lane&31,hi=lane>>5; const int wid=__builtin_amdgcn_readfirstlane(tid>>6);
  const bf16*Qw=Q0+(long)(wid*QBLK)*QP;
  const unsigned lds0=(unsigned)(uintptr_t)shm;
  float*wsf=(float*)(shm+LDS_WS)+wid*64;
  const bf16*ksrc=Kh+(long)lane*QP+wid*8;
  const bf16*vsrc=Vh+(long)(16*(wid&3)+(lane>>2))*QP+(wid>>2)*32+(lane&3)*8;
  const unsigned kdst=lds0+LDS_K+wid*1024, vdst=lds0+LDS_V+wid*1024;
  #define DMA_K(t,slot) glds16(ksrc+(long)(t)*KVBLK*QP,(unsigned)__builtin_amdgcn_readfirstlane(kdst+(slot)))
  #define DMA_V(t,slot) do{ glds16(vsrc+(long)(t)*KVBLK*QP,(unsigned)__builtin_amdgcn_readfirstlane(vdst+2*(slot))); glds16(vsrc+64+(long)(t)*KVBLK*QP,(unsigned)__builtin_amdgcn_readfirstlane(vdst+2*(slot)+8192)); }while(0)
  const int vb0=(int)(lds0+LDS_V)+((lane>>4)&1)*32+(lane&3)*8+(4*hi+((lane&15)>>2))*64;
  const char*Kbase=shm+LDS_K; bf16x8 kf[8];
  const lds_cptr shm3=(lds_cptr)shm; const lds_cptr kp0=shm3+LDS_K+hi*1024+r32*16; const lds_cptr vp0=shm3+LDS_V+((lane>>4)&1)*32+(lane&3)*8+(4*hi+((lane&15)>>2))*64;
  const int NT=4*qb+5;
  DMA_K(0,0);DMA_V(0,0);DMA_K(1,SLOTB);
  bf16x8 qr[4];
  #pragma unroll
  for(int d0=0;d0<4;++d0)qr[d0]=*reinterpret_cast<const bf16x8*>(&Qw[(long)r32*QP+d0*16+hi*8]);
  float mhat=0.f,l_reg=0.f;float z0_=0.f; asm volatile("":"+v"(z0_));
  f32x16 o[4]; _Pragma("unroll") for(int q_=0;q_<4;++q_) _Pragma("unroll") for(int r=0;r<16;++r)o[q_][r]=z0_; f32x16 negm; _Pragma("unroll") for(int r=0;r<16;++r)negm[r]=z0_; asm volatile("":"+v"(negm));
  const int qrel=wid*QBLK+r32;
  #define CMASK(P0,P1,t) do{int jb_=(t)-(NT-4); if(jb_>=0)cmask(P0,P1,jb_,qrel,hi);}while(0)
  bool resc=false;
  #define START(P0,P1) do{ const float rm=rowmax(P0,P1); resc=false; \
    { const float dl=rm; mhat=fadd_s(mhat,dl); \
      _Pragma("unroll") for(int r=0;r<16;++r){P0[r]=fsub_s(P0[r],dl);P1[r]=fsub_s(P1[r],dl);} \
      _Pragma("unroll") for(int r=0;r<16;++r)negm[r]=-mhat; asm volatile("":"+v"(negm)); } \
    _Pragma("unroll") for(int r=0;r<16;++r)P0[r]=__builtin_amdgcn_exp2f(P0[r]); }while(0)
  #define RESC() do{ if(resc){ asm volatile("s_waitcnt lgkmcnt(0)":::"memory"); \
      _Pragma("unroll") for(int d_=0;d_<4;++d_) _Pragma("unroll") for(int r=0;r<16;++r)o[d_][r]*=wsf[crow(r,hi)]; } }while(0)
  f32x16 pA0,pA1,pB0,pB1;
  int sl_prev=0,sl_cur=0,sl_next=SLOTB;
  #define ROT() do{sl_prev=sl_cur;sl_cur=sl_next;sl_next=(sl_next==(NSLOT-1)*SLOTB)?0:sl_next+SLOTB;}while(0)
  DMA_K(2,2*SLOTB);
  WAIT_BAR(4);
  qkt(pA0,pA1,Kbase,qr,negm,r32,hi);asm volatile("s_nop 15\n\ts_nop 7":"+v"(pA0),"+v"(pA1));
  { const float NEGI=-INFINITY;
    _Pragma("unroll") for(int r=0;r<16;++r)pA0[r]=NEGI;
    _Pragma("unroll") for(int r=0;r<8;++r)pA1[r]=NEGI; }
  START(pA0,pA1);
  _Pragma("unroll") for(int r=0;r<16;++r)pA1[r]=__builtin_amdgcn_exp2f(pA1[r]);
  WAIT_BAR(0);
  DMA_K(3,0);DMA_V(1,SLOTB);
  ROT();
  kload8(kf,kp0+sl_cur);
  WAIT_BAR(3);
  s16x4 vlo[4],vhi[4]; u32x4 pw0,pw1,pw2,pw3;
  #define PKW(P,B) cvtpk_s(P[B],P[B+1])
  #define PAF(k) __builtin_bit_cast(bf16x8,pw##k)
  #define VFR(i) (bf16x8){vlo[i][0],vlo[i][1],vlo[i][2],vlo[i][3],vhi[i][0],vhi[i][1],vhi[i][2],vhi[i][3]}
  #define PIN(x) asm volatile("":"+v"(x))
  #define MX3(a,b,c) __builtin_fmaxf(__builtin_fmaxf((a),(b)),(c))
  #define GAPA(MF,A0,A1,A2,A3,W0,W1,PW) do{ MF; sacc+=A0; sacc+=A1; sacc+=A2; sacc+=A3; PIN(sacc); W0; W1; PIN(PW); SBAR(); }while(0)
  #define EX(v) __builtin_amdgcn_exp2f(v)
  #define GAPB(MF,X,B) do{ MF; X[B]=EX(X[B]); X[B+1]=EX(X[B+1]); PIN(X); SBAR(); }while(0)
  #define VRD(s,i) do{ vlo[s]=vtr(vp_+(((i)>>2)*4096+((i)&3)*1024)); vhi[s]=vtr(vp_+(((i)>>2)*4096+((i)&3)*1024+512)); }while(0)
  #define KRD(G,j) do{ if(G){ kload2(kf,kp0+sl_next,j); SBAR(); } }while(0)
  #define STEP(C0,C1,P0,P1,t,GK,GV,GL) do{ SBAR(); \
    const lds_cptr vp_=vp0+2*sl_prev; \
    VRD(0,0); SBAR(); float sacc=(P0[0]+P0[1]); \
    GAPA(C0=__builtin_amdgcn_mfma_f32_32x32x16_bf16(kf[0],qr[0],negm,0,0,0), P0[2],P0[3],P0[4],P0[5],     pw0[0]=PKW(P0,0), pw0[1]=PKW(P0,2), pw0); \
    VRD(1,4); SBAR(); GAPA(C1=__builtin_amdgcn_mfma_f32_32x32x16_bf16(kf[1],qr[0],negm,0,0,0), P0[6],P0[7],P0[8],P0[9],     pw0[2]=PKW(P0,4), pw0[3]=PKW(P0,6), pw0); \
    VRD(2,8); SBAR(); GAPA(C0=__builtin_amdgcn_mfma_f32_32x32x16_bf16(kf[2],qr[1],C0,0,0,0),   P0[10],P0[11],P0[12],P0[13], pw1[0]=PKW(P0,8), pw1[1]=PKW(P0,10), pw1); \
    VRD(3,12); SBAR(); GAPA(C1=__builtin_amdgcn_mfma_f32_32x32x16_bf16(kf[3],qr[1],C1,0,0,0),   P0[14],P0[15],P1[0],P1[1],   pw1[2]=PKW(P0,12),pw1[3]=PKW(P0,14), pw1); \
    GAPA(C0=__builtin_amdgcn_mfma_f32_32x32x16_bf16(kf[4],qr[2],C0,0,0,0),   P1[2],P1[3],P1[4],P1[5],     pw2[0]=PKW(P1,0), pw2[1]=PKW(P1,2), pw2); \
    GAPA(C1=__builtin_amdgcn_mfma_f32_32x32x16_bf16(kf[5],qr[2],C1,0,0,0),   P1[6],P1[7],P1[8],P1[9],     pw2[2]=PKW(P1,4), pw2[3]=PKW(P1,6), pw2); \
    GAPA(C0=__builtin_amdgcn_mfma_f32_32x32x16_bf16(kf[6],qr[3],C0,0,0,0),   P1[10],P1[11],P1[12],P1[13], pw3[0]=PKW(P1,8), pw3[1]=PKW(P1,10), pw3); \
    GAPA(C1=__builtin_amdgcn_mfma_f32_32x32x16_bf16(kf[7],qr[3],C1,0,0,0),   P1[14],P1[15],0.f,0.f,       pw3[2]=PKW(P1,12),pw3[3]=PKW(P1,14), pw3); \
    l_reg+=sacc; \
    if(GK){DMA_K((t)+3,sl_cur);} if(GV){DMA_V((t)+1,sl_next);} \
    CMASK(C0,C1,t); \
    { float a=MX3(C0[0],C0[1],C1[0]),b=MX3(C0[2],C0[3],C1[1]); a=MX3(a,C1[2],C1[3]); \
      _Pragma("unroll") for(int r=4;r<16;r+=4){a=MX3(a,C0[r],C0[r+1]);b=MX3(b,C0[r+2],C0[r+3]);a=MX3(a,C1[r],C1[r+1]);b=MX3(b,C1[r+2],C1[r+3]);} \
      float rm=__builtin_fmaxf(a,b); { auto rr=__builtin_amdgcn_permlane32_swap(__float_as_uint(rm),__float_as_uint(rm),false,false); rm=__builtin_fmaxf(__uint_as_float(rr[0]),__uint_as_float(rr[1])); } \
      resc=false; \
      if(__builtin_expect(__any(rm>(float)THRL),0)){ const float dl=__builtin_fmaxf(rm,0.f); mhat+=dl; \
        _Pragma("unroll") for(int r=0;r<16;++r){C0[r]-=dl;C1[r]-=dl;} \
        _Pragma("unroll") for(int r=0;r<16;++r)negm[r]=-mhat; asm volatile("":"+v"(negm)); \
        const float f=__builtin_amdgcn_exp2f(-dl); l_reg*=f; if(hi==0)wsf[r32]=f; resc=true; } } \
    SBAR(); \
    GAPB(o[0]=__builtin_amdgcn_mfma_f32_32x32x16_bf16(PAF(0),VFR(0),o[0],0,0,0), C0,0);  VRD(0,1);  SBAR(); \
    GAPB(o[1]=__builtin_amdgcn_mfma_f32_32x32x16_bf16(PAF(0),VFR(1),o[1],0,0,0), C0,2);  VRD(1,5);  SBAR(); \
    GAPB(o[2]=__builtin_amdgcn_mfma_f32_32x32x16_bf16(PAF(0),VFR(2),o[2],0,0,0), C0,4);  VRD(2,9);  SBAR(); \
    GAPB(o[3]=__builtin_amdgcn_mfma_f32_32x32x16_bf16(PAF(0),VFR(3),o[3],0,0,0), C0,6);  VRD(3,13); SBAR(); \
    GAPB(o[0]=__builtin_amdgcn_mfma_f32_32x32x16_bf16(PAF(1),VFR(0),o[0],0,0,0), C0,8);  VRD(0,2);  SBAR(); \
    KRD(GL,0); GAPB(o[1]=__builtin_amdgcn_mfma_f32_32x32x16_bf16(PAF(1),VFR(1),o[1],0,0,0), C0,10); VRD(1,6);  SBAR(); \
    GAPB(o[2]=__builtin_amdgcn_mfma_f32_32x32x16_bf16(PAF(1),VFR(2),o[2],0,0,0), C0,12); VRD(2,10); SBAR(); \
    KRD(GL,1); GAPB(o[3]=__builtin_amdgcn_mfma_f32_32x32x16_bf16(PAF(1),VFR(3),o[3],0,0,0), C0,14); VRD(3,14); SBAR(); \
    GAPB(o[0]=__builtin_amdgcn_mfma_f32_32x32x16_bf16(PAF(2),VFR(0),o[0],0,0,0), C1,0);  VRD(0,3);  SBAR(); \
    KRD(GL,2); GAPB(o[1]=__builtin_amdgcn_mfma_f32_32x32x16_bf16(PAF(2),VFR(1),o[1],0,0,0), C1,2);  VRD(1,7);  SBAR(); \
    GAPB(o[2]=__builtin_amdgcn_mfma_f32_32x32x16_bf16(PAF(2),VFR(2),o[2],0,0,0), C1,4);  VRD(2,11); SBAR(); \
    KRD(GL,3); GAPB(o[3]=__builtin_amdgcn_mfma_f32_32x32x16_bf16(PAF(2),VFR(3),o[3],0,0,0), C1,6);  VRD(3,15); SBAR(); \
    GAPB(o[0]=__builtin_amdgcn_mfma_f32_32x32x16_bf16(PAF(3),VFR(0),o[0],0,0,0), C1,8); \
    GAPB(o[1]=__builtin_amdgcn_mfma_f32_32x32x16_bf16(PAF(3),VFR(1),o[1],0,0,0), C1,10); \
    GAPB(o[2]=__builtin_amdgcn_mfma_f32_32x32x16_bf16(PAF(3),VFR(2),o[2],0,0,0), C1,12); \
    GAPB(o[3]=__builtin_amdgcn_mfma_f32_32x32x16_bf16(PAF(3),VFR(3),o[3],0,0,0), C1,14); \
    }while(0)
  int t=1;
  #undef CMASK
  #define CMASK(P0,P1,t) do{}while(0)
  for(;t+5<NT;t+=2){
    STEP(pB0,pB1,pA0,pA1,t,true,true,true);     WAIT_BAR(3); RESC(); ROT();
    STEP(pA0,pA1,pB0,pB1,t+1,true,true,true);   WAIT_BAR(3); RESC(); ROT();
  }
  #undef CMASK
  #define CMASK(P0,P1,t) do{int jb_=(t)-(NT-4); if(jb_>=0)cmask(P0,P1,jb_,qrel,hi);}while(0)
  #define ENDW(tt) do{ if((tt)+3<NT){WAIT_BAR(3);} else if((tt)+2<NT){WAIT_BAR(2);} else {WAIT_BAR(0);} }while(0)
  for(;t+3<NT;t+=2){
    STEP(pB0,pB1,pA0,pA1,t,(t+3<NT),(t+1<NT),(t+1<NT));       ENDW(t);   RESC(); ROT();
    STEP(pA0,pA1,pB0,pB1,t+1,(t+4<NT),(t+2<NT),(t+2<NT));     ENDW(t+1); RESC(); ROT();
  }
  STEP(pB0,pB1,pA0,pA1,t,false,true,true);        WAIT_BAR(0); RESC(); ROT();
  STEP(pA0,pA1,pB0,pB1,NT-1,false,false,false); RESC();
  { float sacc=pA0[0]+pA0[1]; _Pragma("unroll") for(int r=2;r<16;++r)sacc+=pA0[r]; _Pragma("unroll") for(int r=0;r<16;++r)sacc+=pA1[r]; l_reg+=sacc;
    pw0=(u32x4){PKW(pA0,0),PKW(pA0,2),PKW(pA0,4),PKW(pA0,6)};pw1=(u32x4){PKW(pA0,8),PKW(pA0,10),PKW(pA0,12),PKW(pA0,14)};pw2=(u32x4){PKW(pA1,0),PKW(pA1,2),PKW(pA1,4),PKW(pA1,6)};pw3=(u32x4){PKW(pA1,8),PKW(pA1,10),PKW(pA1,12),PKW(pA1,14)};
    SBAR(); pv(o,vb0+2*sl_cur,PAF(0),PAF(1),PAF(2),PAF(3)); }
  #undef PKW
  #undef PAF
  #undef VFR
  #undef PIN
  #undef MX3
  #undef GAPA
  #undef GAPB
  #undef EX
  #undef VRD
  #undef KRD
  #undef STEP
  #undef ENDW
  {auto rr=__builtin_amdgcn_permlane32_swap(__float_as_uint(l_reg),__float_as_uint(l_reg),false,false);l_reg=__uint_as_float(rr[0])+__uint_as_float(rr[1]);}
  if(hi==0)wsf[32+r32]=l_reg;asm volatile("s_waitcnt lgkmcnt(0)":::"memory");
  float rli[16];
  #pragma unroll
  for(int r=0;r<16;++r)rli[r]=__builtin_amdgcn_rcpf(wsf[32+crow(r,hi)]);
  #pragma unroll
  for(int q_=0;q_<4;++q_) _Pragma("unroll") for(int r=0;r<16;++r)o[q_][r]*=rli[r];
  f32x4*sc4=(f32x4*)oscr+(size_t)wid*16*64+lane;
  if(mode==0){
    #pragma unroll
    for(int q_=0;q_<4;++q_) _Pragma("unroll") for(int j=0;j<4;++j) sc4[(q_*4+j)*64]=(f32x4){o[q_][4*j],o[q_][4*j+1],o[q_][4*j+2],o[q_][4*j+3]};
  } else {
    float ss[16];
    #pragma unroll
    for(int r=0;r<16;++r)ss[r]=0.f;
    #pragma unroll
    for(int q_=0;q_<4;++q_) _Pragma("unroll") for(int j=0;j<4;++j){ const f32x4 a=sc4[(q_*4+j)*64];
      _Pragma("unroll") for(int e=0;e<4;++e){ const float d=a[e]-lam*o[q_][4*j+e]; o[q_][4*j+e]=d; ss[4*j+e]+=d*d; } }
    #pragma unroll
    for(int r=0;r<16;++r){ float v=ss[r]; v+=__shfl_xor(v,1); v+=__shfl_xor(v,2); v+=__shfl_xor(v,4); v+=__shfl_xor(v,8); v+=__shfl_xor(v,16); ss[r]=__builtin_amdgcn_rsqf(v*(1.0f/128.0f)+1e-5f); }
    bf16*Ow=O0+(long)(wid*QBLK)*OP;
    bf16*stg=(bf16*)(shm+LDS_OST)+wid*2048;
    #pragma unroll
    for(int dh=0;dh<2;++dh){
      #pragma unroll
      for(int r=0;r<16;++r){const int orow=crow(r,hi);
        #pragma unroll
        for(int d0=0;d0<2;++d0)stg[orow*64+d0*32+r32]=__float2bfloat16(o[2*dh+d0][r]*ss[r]);}
      asm volatile("s_waitcnt lgkmcnt(0)":::"memory");
      #pragma unroll
      for(int i=0;i<4;++i){const int row=i*8+(lane>>3),ch=lane&7; const u32x4 v=*(const u32x4*)(stg+row*64+ch*8); ATTN_STORE16(Ow+(long)row*OP+dh*64+ch*8,v);}
      asm volatile("s_waitcnt lgkmcnt(0)":::"memory"); } }
  asm volatile("s_waitcnt lgkmcnt(0)\n\ts_barrier":::"memory");
  #undef DMA_K
  #undef DMA_V
  #undef CMASK
  #undef START
  #undef RESC
  #undef ROT
}
constexpr int ATTN_LDS_BYTES=LDS_BYTES;
#undef SBAR
#undef WAIT_BAR
}

#define GAS __attribute__((address_space(1)))
#define LAS __attribute__((address_space(3)))
typedef unsigned short bf16;
typedef unsigned v4u __attribute__((ext_vector_type(4)));
typedef float f32x4 __attribute__((ext_vector_type(4)));
typedef short bf16x8 __attribute__((ext_vector_type(8)));
typedef GAS unsigned gu32;
typedef GAS unsigned long long gu64;
#define RLX_AGENT __ATOMIC_RELAXED, __HIP_MEMORY_SCOPE_AGENT
#define LDS_WAIT() asm volatile("s_waitcnt lgkmcnt(0)" ::: "memory")
#define VM_WAIT() asm volatile("s_waitcnt vmcnt(0)" ::: "memory")
__device__ __forceinline__ unsigned long long rt() { return __builtin_amdgcn_s_memrealtime(); }
__device__ __forceinline__ unsigned f2bf(float f) { unsigned u = __builtin_bit_cast(unsigned, f); return (u + 0x7fffu + ((u >> 16) & 1u)) >> 16; }
__device__ __forceinline__ unsigned pk2(float lo, float hi) { return f2bf(lo) | (f2bf(hi) << 16); }

#define XB_TMO      128
#define XB_XCNT(j)  (256  + 64 * (j))
#define XB_XSUB(j)  (1280 + 64 * (j))
#define XB_XGEN(j)  (2304 + 64 * (j))
#define XB_TOP      3328
#define XB_TOPGEN   3392
#define XCD_BAR_WORDS 3456
#define XB_SPIN_CAP (1u << 18)

__device__ __forceinline__ unsigned xb_ld(unsigned* p)              { return __hip_atomic_load(p, __ATOMIC_RELAXED, __HIP_MEMORY_SCOPE_AGENT); }
__device__ __forceinline__ unsigned xb_add(unsigned* p, unsigned v) { return __hip_atomic_fetch_add(p, v, __ATOMIC_RELAXED, __HIP_MEMORY_SCOPE_AGENT); }
__device__ __forceinline__ unsigned xb_xcc_id() { return (unsigned)__builtin_amdgcn_s_getreg((3 << 11) | 20) & 0xFu; }
#define XB_SPIN(cond, bar) do { unsigned _sp = 0; while (cond) { __builtin_amdgcn_s_sleep(1); \
    if ((++_sp & 255u) == 0u) { if (xb_ld(&(bar)[XB_TMO])) break; if (_sp > XB_SPIN_CAP) { atomicAdd(&(bar)[XB_TMO], 1u); break; } } } } while (0)

struct XcdBarrier {
    unsigned* bar; unsigned x;
    volatile LAS unsigned* st;
};

__device__ __forceinline__ XcdBarrier xcd_barrier_post(unsigned* bar, volatile LAS unsigned* st) {
    XcdBarrier b; b.bar = bar; b.x = xb_xcc_id(); b.st = st;
    if (threadIdx.x == 0) (void)xb_add(&bar[XB_XCNT(b.x)], 1u);
    return b;
}
__device__ __forceinline__ void xcd_barrier_complete(unsigned* bar, unsigned x, unsigned& nloc, unsigned& nx) {
    const unsigned G = gridDim.x * gridDim.y * gridDim.z;
    unsigned sum, cnt, mine, sp = 0u;
    for (;;) {
        sum = 0u; cnt = 0u; mine = 0u;
#pragma unroll
        for (unsigned j = 0; j < 16; ++j) { const unsigned c = xb_ld(&bar[XB_XCNT(j)]); sum += c; cnt += (c > 0u) ? 1u : 0u; mine = (j == x) ? c : mine; }
        if (sum == G) break;
        __builtin_amdgcn_s_sleep(1);
        if ((++sp & 255u) == 0u) { if (xb_ld(&bar[XB_TMO])) break; if (sp > XB_SPIN_CAP) { atomicAdd(&bar[XB_TMO], 1u); break; } }
    }
    nloc = mine > 0u ? mine : 1u; nx = cnt > 0u ? cnt : 1u;
}

__device__ __forceinline__ void xcd_barrier(const XcdBarrier& b) {
    asm volatile("s_waitcnt vmcnt(0)" ::: "memory");
    __syncthreads();
    if (threadIdx.x == 0) {
        unsigned* bar = b.bar;
        __builtin_amdgcn_s_waitcnt(0);
        unsigned nloc = b.st[0], nx = b.st[1];
        if (nloc == 0u) { xcd_barrier_complete(bar, b.x, nloc, nx); b.st[0] = nloc; b.st[1] = nx; }
        const unsigned old = xb_add(&bar[XB_XSUB(b.x)], 1u);
        const unsigned gen = old / nloc;
        if (old + 1u == (gen + 1u) * nloc) {
            __builtin_amdgcn_fence(__ATOMIC_RELEASE, "agent");
            asm volatile("s_waitcnt vmcnt(0)" ::: "memory");
            const unsigned og = xb_add(&bar[XB_TOP], 1u);
            const unsigned tg = og / nx;
            if (og + 1u == (tg + 1u) * nx) xb_add(&bar[XB_TOPGEN], 1u);
            else XB_SPIN(xb_ld(&bar[XB_TOPGEN]) == tg, bar);
            __builtin_amdgcn_fence(__ATOMIC_ACQUIRE, "agent");
            xb_add(&bar[XB_XGEN(b.x)], 1u);
            asm volatile("s_waitcnt vmcnt(0)" ::: "memory");
        } else {
            XB_SPIN(xb_ld(&bar[XB_XGEN(b.x)]) == gen, bar);
            __builtin_amdgcn_fence(__ATOMIC_ACQUIRE, "agent");
            asm volatile("s_waitcnt vmcnt(0)" ::: "memory");
        }
    }
    __syncthreads();
}

constexpr size_t MiB = 1u << 20;
constexpr size_t WS_CTL = 0, CTL_ZERO_BYTES = 1 * MiB;
constexpr size_t WS_ROPE = 1 * MiB;
constexpr size_t WS_SSQ = 2 * MiB;
constexpr size_t SSQ_SET = (size_t)8 * MROWS * 4;
constexpr size_t WS_HM = 16 * MiB;
constexpr size_t WS_MIDM = 17 * MiB;
constexpr size_t WS_CATM = 18 * MiB;
constexpr size_t WS_SSQM = 19 * MiB;
constexpr size_t SSQM_SET = (size_t)128 * 16 * 4;
constexpr size_t WS_HM16 = 20 * MiB;
constexpr size_t WS_H16 = 32 * MiB;
constexpr size_t WS_OSCR = 168 * MiB;
constexpr size_t WS_HB = 200 * MiB;
constexpr size_t WS_BIG = 336 * MiB;
constexpr size_t WS_PROJ = WS_BIG, WS_CAT = WS_BIG + 273 * MiB, WS_MID = WS_BIG;
constexpr size_t WS_WTS = 745 * MiB;
constexpr size_t WL_GU1 = 0, WL_D1 = 47 * MiB, WL_IN = 70 * MiB, WL_OUT = 87 * MiB, WL_GU2 = 96 * MiB, WL_D2 = 143 * MiB, WL_BYTES = 166 * MiB;
constexpr size_t WS_END = WS_WTS + 4 * WL_BYTES;
static_assert(SSQ_SET * 13 <= 14 * MiB && (size_t)MREAL * LDH * 2 <= 136 * MiB && (size_t)MREAL * LDM * 2 <= 409 * MiB && (size_t)VROWS * LDP * 2 <= 273 * MiB && WS_CAT + (size_t)MREAL * LDH * 2 <= WS_WTS && WS_H16 + 136 * MiB <= WS_OSCR && WS_OSCR + 32 * MiB <= WS_HB && WS_HB + 136 * MiB <= WS_BIG, "d_ws map");
static_assert((size_t)2 * FF_ * LDH * 2 <= 47 * MiB && (size_t)D_ * LDM * 2 <= 23 * MiB && (size_t)INW * LDH * 2 <= 17 * MiB && (size_t)D_ * LDH * 2 <= 9 * MiB, "weight map");
constexpr int CW_BAR = 4096;
constexpr int NPHASE = 2 + 8 * DEPTH + 1;

constexpr int RING_OFF = 0, RING_BYTES = 131072;
constexpr int LDSCTL_OFF = RING_BYTES;
constexpr int XR_OFF = LDSCTL_OFF, MISC_OFF = LDSCTL_OFF + 4352;
constexpr int LDS_BYTES = 147456;
static_assert(MISC_OFF + 128 <= LDS_BYTES, "LDS map");
constexpr int NWAVES = 8;

struct Args { const float* in[21]; float* out; unsigned char* ws; int ph_lo, ph_hi; float lam_init[4]; };
struct Frame {
    LAS unsigned char* lds; volatile LAS unsigned* MISC; gu32* ctl;
    int wave, vcu, G;
};
__device__ __forceinline__ float wave_sum(float v) {
#pragma unroll
    for (int o = 1; o < 64; o <<= 1) v += __shfl_xor(v, o);
    return v;
}
__device__ __forceinline__ float bf_lo(unsigned w) { return __builtin_bit_cast(float, w << 16); }
__device__ __forceinline__ float bf_hi(unsigned w) { return __builtin_bit_cast(float, w & 0xffff0000u); }

#ifndef H16_MASTER
#define H16_MASTER 1
#endif
__device__ __forceinline__ void fold_item(const float* w_in, const float* w_pool, const float* pool_scale, const float* kgain, bf16* WTin, int item, int lane) {

    const int k0 = (item & 255) * 8, g = (item >> 8) & 3, L = item >> 10;
    const float* A = w_in + ((size_t)L * D_ + k0) * INW + 3072 + 256 * g;
    const float* Bm = w_pool + ((size_t)(L * 4 + g) * 256) * 256 + 4 * lane;
    f32x4 acc[8];
#pragma unroll
    for (int r = 0; r < 8; ++r) acc[r] = (f32x4){0.f, 0.f, 0.f, 0.f};
#pragma unroll 1
    for (int cc = 0; cc < 256; cc += 16) {
        f32x4 b[16], a[8][4];
#pragma unroll
        for (int q = 0; q < 16; ++q) b[q] = *(const f32x4*)(Bm + (size_t)(cc + q) * 256);
#pragma unroll
        for (int r = 0; r < 8; ++r)
#pragma unroll
            for (int q4 = 0; q4 < 4; ++q4) a[r][q4] = *(const f32x4*)(A + (size_t)r * INW + cc + 4 * q4);
#pragma unroll
        for (int r = 0; r < 8; ++r)
#pragma unroll
            for (int q4 = 0; q4 < 4; ++q4) acc[r] = acc[r] + b[4 * q4] * a[r][q4][0] + b[4 * q4 + 1] * a[r][q4][1] + b[4 * q4 + 2] * a[r][q4][2] + b[4 * q4 + 3] * a[r][q4][3];
    }
    const f32x4 sc = *(const f32x4*)(pool_scale + (size_t)L * 1024 + 256 * g + 4 * lane);
    float gk[8];
#pragma unroll
    for (int r = 0; r < 8; ++r) gk[r] = kgain[(size_t)L * D_ + k0 + r];
#pragma unroll
    for (int jj = 0; jj < 4; ++jj) { float o[8];
#pragma unroll
        for (int r = 0; r < 8; ++r) o[r] = acc[r][jj] * sc[jj] * gk[r];
        v4u w;
        if (!H16_MASTER) { w.x = pg8::pk_f16(o[0], o[1]); w.y = pg8::pk_f16(o[2], o[3]); w.z = pg8::pk_f16(o[4], o[5]); w.w = pg8::pk_f16(o[6], o[7]); }
        else { w.x = pk2(o[0], o[1]); w.y = pk2(o[2], o[3]); w.z = pk2(o[4], o[5]); w.w = pk2(o[6], o[7]); }
        *(v4u*)(WTin + ((size_t)(3072 + 256 * g + 4 * lane + jj)) * LDH + k0) = w; }
}
__device__ __forceinline__ void hinit_row(const float* x, const float* meta, bf16* HB, bf16* H16, float* ssq0, int row, int lane) {
    const float* src = row < MREAL ? x + (size_t)row * D_ : meta + (size_t)((row - MREAL) & 15) * D_;
    const f32x4* s4 = (const f32x4*)src + lane;
    unsigned long long* b8 = (unsigned long long*)(HB + (size_t)row * LDH) + lane;
    float ss = 0.f;
#pragma unroll
    for (int j = 0; j < 8; ++j) { const f32x4 v = s4[64 * j]; ss += (v.x * v.x + v.y * v.y) + (v.z * v.z + v.w * v.w);
        const unsigned long long wf = (unsigned long long)pg8::pk_f16(v.x, v.y) | ((unsigned long long)pg8::pk_f16(v.z, v.w) << 32);
        if (H16) { ((unsigned long long*)(H16 + (size_t)row * LDH) + lane)[64 * j] = wf; b8[64 * j] = (unsigned long long)pk2(v.x, v.y) | ((unsigned long long)pk2(v.z, v.w) << 32); } else b8[64 * j] = wf; }
    ss = wave_sum(ss);
    if (lane < 8) ssq0[(size_t)lane * MROWS + row] = lane == 0 ? ss : 0.f;
}
__device__ __forceinline__ void hinit_meta(const float* meta, bf16* HM, bf16* HM16, float* ssqm0, int j, int lane) {
    const f32x4* s4 = (const f32x4*)(meta + (size_t)j * D_) + lane; unsigned long long* b8 = (unsigned long long*)(HM + (size_t)j * D_) + lane; float ss = 0.f;
#pragma unroll
    for (int q = 0; q < 8; ++q) { const f32x4 v = s4[64 * q]; ss += (v.x * v.x + v.y * v.y) + (v.z * v.z + v.w * v.w);
        const unsigned long long wf = (unsigned long long)pg8::pk_f16(v.x, v.y) | ((unsigned long long)pg8::pk_f16(v.z, v.w) << 32);
        if (HM16) { ((unsigned long long*)(HM16 + (size_t)j * D_) + lane)[64 * q] = wf; b8[64 * q] = (unsigned long long)pk2(v.x, v.y) | ((unsigned long long)pk2(v.z, v.w) << 32); } else b8[64 * q] = wf; }
    ss = wave_sum(ss);
    for (int q = lane; q < 128; q += 64) ssqm0[q * 16 + j] = q == 0 ? ss : 0.f;
}
template <bool F16, int NACC, int BS = 8  > __device__ __forceinline__ void thin_mma(f32x4 (&acc)[NACC], const bf16* A16, const bf16* Bt, int K, const int (&c0)[NACC], int wave, int lane, LAS float* red) {

    const int fr = lane & 15, fq = lane >> 4, kw = K >> 3;
#pragma unroll
    for (int a = 0; a < NACC; ++a) acc[a] = (f32x4){0.f, 0.f, 0.f, 0.f};
    const bf16* ap = A16 + (size_t)fr * K + wave * kw + 8 * fq;
    const bf16* bp[NACC];
#pragma unroll
    for (int a = 0; a < NACC; ++a) bp[a] = Bt + (size_t)(c0[a] + fr) * (K + 128) + wave * kw + 8 * fq;
    for (int kb = 0; kb < kw; kb += 32 * BS) {
        const int ns = (kw - kb) >= 32 * BS ? BS : ((kw - kb) >> 5);
        bf16x8 av[BS], bv[NACC][BS];
#pragma unroll
        for (int s = 0; s < BS; ++s) { const int k = kb + 32 * (s < ns ? s : 0); av[s] = *(const bf16x8*)(ap + k);
#pragma unroll
            for (int a = 0; a < NACC; ++a) bv[a][s] = *(const bf16x8*)(bp[a] + k); }
#pragma unroll
        for (int s = 0; s < BS; ++s) if (s < ns) {
#pragma unroll
            for (int a = 0; a < NACC; ++a) acc[a] = pg8::mma16<F16>(bv[a][s], av[s], acc[a]); } }
#pragma unroll
    for (int a = 0; a < NACC; ++a) *(LAS f32x4*)(red + ((wave * NACC + a) * 64 + lane) * 4) = acc[a];
    __syncthreads();
    if (wave == 0) {
#pragma unroll
        for (int w = 1; w < 8; ++w)
#pragma unroll
            for (int a = 0; a < NACC; ++a) acc[a] = acc[a] + *(const LAS f32x4*)(red + ((w * NACC + a) * 64 + lane) * 4);
    }
    __syncthreads();
}
__device__ __forceinline__ float meta_rstd(const float* ssqm, int lane) {
    const int fr = lane & 15, fq = lane >> 4; float s = 0.f;
#pragma unroll 8
    for (int q = 0; q < 32; ++q) s += ssqm[(fq * 32 + q) * 16 + fr];
    s += __shfl_xor(s, 16); s += __shfl_xor(s, 32);
    return __builtin_amdgcn_rsqf(s * (1.0f / 2048.0f) + NORM_EPS);
}
typedef unsigned u32x2t __attribute__((ext_vector_type(2)));
template <bool F16> __device__ __forceinline__ void thin_gu(const bf16* HM, const bf16* Bt, const float* ssqm, bf16* MIDM, int vcu, int G, int wave, int lane, LAS float* red) {
    for (int t = vcu; t < FF_ / 32; t += G) { const int cb = 256 * (t >> 2) + 32 * (t & 3); const int c0[4] = {cb, cb + 16, cb + 128, cb + 144}; f32x4 acc[4];
        float r = 0.f; if (wave == 0) r = meta_rstd(ssqm, lane);
        thin_mma<F16, 4>(acc, HM, Bt, D_, c0, wave, lane, red);
        if (wave == 0) { const int fr = lane & 15, fq = lane >> 4;
#pragma unroll
            for (int hf = 0; hf < 2; ++hf) { const f32x4 g = acc[hf] * r, up = acc[2 + hf] * r; f32x4 o;
#pragma unroll
                for (int i = 0; i < 4; ++i) o[i] = g[i] * up[i] * __builtin_amdgcn_rcpf(1.0f + __builtin_amdgcn_exp2f(g[i] * -1.4426950408889634f));
                u32x2t w; w.x = pk2(o[0], o[1]); w.y = pk2(o[2], o[3]); *(u32x2t*)(MIDM + (size_t)fr * FF_ + 32 * t + 16 * hf + 4 * fq) = w; } } }
}
template <int BS> __device__ __forceinline__ void thin_resid(const bf16* A16, const bf16* Bt, int K, bf16* HM, bf16* HM16, float* ssqm_out, float scale, int vcu, int G, int wave, int lane, LAS float* red) {
    for (int t = vcu; t < D_ / 16; t += G) { const int c0[1] = {16 * t}; f32x4 acc[1];
        u32x2t* hp = (u32x2t*)((HM16 ? HM16 : HM) + (size_t)(lane & 15) * D_ + 16 * t + 4 * (lane >> 4)); u32x2t o = (u32x2t){0u, 0u}; if (wave == 0) o = *hp;
        thin_mma<false, 1, BS>(acc, A16, Bt, K, c0, wave, lane, red);
        if (wave == 0) { const int fr = lane & 15, fq = lane >> 4;
            f32x4 h = (f32x4){pg8::f16_lo(o.x), pg8::f16_hi(o.x), pg8::f16_lo(o.y), pg8::f16_hi(o.y)}; h = h + acc[0] * scale;
            u32x2t w; w.x = pg8::pk_f16(h[0], h[1]); w.y = pg8::pk_f16(h[2], h[3]); *hp = w;
            if (HM16) { u32x2t wb; wb.x = pk2(h[0], h[1]); wb.y = pk2(h[2], h[3]); *(u32x2t*)(HM + (size_t)fr * D_ + 16 * t + 4 * fq) = wb; }
            float s = (h[0] * h[0] + h[1] * h[1]) + (h[2] * h[2] + h[3] * h[3]); s += __shfl_xor(s, 16); s += __shfl_xor(s, 32);
            if (fq == 0) ssqm_out[t * 16 + fr] = s; } }
}
template <bool F16> __device__ __forceinline__ void thin_proj(const bf16* HM, const bf16* Bt, const float* ssqm, bf16* P, const float* rcos, const float* rsin, int vcu, int G, int wave, int lane, LAS float* red) {
    for (int t = vcu; t < INW / 16; t += G) { const int c0[1] = {16 * t}; f32x4 acc[1];
        float r = 0.f; if (wave == 0) r = meta_rstd(ssqm, lane);
        thin_mma<F16, 1>(acc, HM, Bt, D_, c0, wave, lane, red);
        if (wave == 0) { const int fr = lane & 15, fq = lane >> 4; int col; f32x4 o;
            if (t < 128) { if (t < 64) r *= QSCALE; const int pb = (16 * t) & 63, n = fq & 1, dlo = 16 * (pb >> 5) + 4 * ((((pb >> 3) & 3) + (fq >> 1)) & 3);
                const f32x4 own = acc[0] * r; f32x4 oth;
#pragma unroll
                for (int i = 0; i < 4; ++i) oth[i] = __shfl_xor(own[i], 16);
                const f32x4 c = *(const f32x4*)(rcos + fr * 32 + dlo), s = *(const f32x4*)(rsin + fr * 32 + dlo);
                o = n ? (own * c + oth * s) : (own * c - oth * s); col = ((16 * t) & ~63) + 32 * n + dlo; }
            else { o = acc[0] * r; col = 16 * t + 4 * fq; }
            u32x2t w; w.x = pk2(o[0], o[1]); w.y = pk2(o[2], o[3]);
#pragma unroll 4
            for (int b = 0; b < NBATCH; ++b) *(u32x2t*)(P + (size_t)(b * VSEQ + 48 + fr) * LDP + col) = w; } }
}
__device__ __forceinline__ void conv_item(int kind, const float* W0, const float* W1, const float* kgain, float aux, bf16* WT, int K, int nsrc, int nnb, int item, int lane) {
    const int kb = item / nnb, nb = item - kb * nnb, c = nb * 64 + lane, k0 = kb * 256;
    const float* src; int pitch = nsrc;
    if (kind == 1) { const int pn = c >> 8, bj = (c >> 7) & 1, j = 128 * pn + (c & 127); src = (bj ? W1 : W0) + j; }
    else if (kind == 2) {
        if (c < 2048) { const int p = c & 63; const int d = 32 * ((p >> 2) & 1) + 16 * (p >> 5) + 4 * ((p >> 3) & 3) + (p & 3); src = W0 + (c & ~63) + d; }
        else src = W0 + c;
    } else src = W0 + c;
    src += (size_t)k0 * pitch;
    bf16* dst = WT + (size_t)c * (K + 128) + k0;
    float v[32];
#pragma unroll
    for (int e = 0; e < 32; ++e) v[e] = src[(size_t)e * pitch];
#pragma unroll 1
    for (int kc = 0; kc < 8; ++kc) {
        float nv[32];
        const int kn = kc < 7 ? kc + 1 : kc;
#pragma unroll
        for (int e = 0; e < 32; ++e) nv[e] = src[(size_t)(kn * 32 + e) * pitch];
#pragma unroll
        for (int e = 0; e < 32; ++e) { const int k = k0 + kc * 32 + e; float gk = 1.f;
            if (kind == 1 || kind == 2) gk = kgain[k]; else if (kind == 3) gk = k < 1024 ? kgain[k & 127] * aux : 1.f;
            v[e] *= gk; }
#pragma unroll
        for (int q = 0; q < 4; ++q) { v4u o;
            if (!H16_MASTER && (kind == 1 || kind == 2)) { o.x = pg8::pk_f16(v[8 * q], v[8 * q + 1]); o.y = pg8::pk_f16(v[8 * q + 2], v[8 * q + 3]); o.z = pg8::pk_f16(v[8 * q + 4], v[8 * q + 5]); o.w = pg8::pk_f16(v[8 * q + 6], v[8 * q + 7]); }
            else { o.x = pk2(v[8 * q], v[8 * q + 1]); o.y = pk2(v[8 * q + 2], v[8 * q + 3]); o.z = pk2(v[8 * q + 4], v[8 * q + 5]); o.w = pk2(v[8 * q + 6], v[8 * q + 7]); }
            *(v4u*)(dst + kc * 32 + 8 * q) = o; }
#pragma unroll
        for (int e = 0; e < 32; ++e) v[e] = nv[e];
    }
}
__device__ __forceinline__ const float* conv_src(int kind, const float* W0, const float* W1, int c) {
    if (kind == 1) { const int pn = c >> 8, bj = (c >> 7) & 1, j = 128 * pn + (c & 127); return (bj ? W1 : W0) + j; }
    if (kind == 2 && c < 2048) { const int pp = c & 63; const int d = 32 * ((pp >> 2) & 1) + 16 * (pp >> 5) + 4 * ((pp >> 3) & 3); return W0 + (c & ~63) + d; }
    return W0 + c;
}
__device__ __forceinline__ void conv_run(int kind, const float* W0, const float* W1, const float* kgain, float aux, bf16* WT, int K, int nsrc, int nnb, int nitems, int gw, int NGW, int lane_in, LAS float* scr) {
    int lane = lane_in; asm volatile("" : "+v"(lane));
    const int kq = lane >> 3, n4 = lane & 7, ch = lane & 7, rn = lane >> 3;
    f32x4 v[8];
    int it = gw;
    if (it < nitems) { const int kb = it / nnb, nb = it - kb * nnb; const float* s = conv_src(kind, W0, W1, nb * 32 + 4 * n4) + (size_t)(kb * 64 + kq) * nsrc;
#pragma unroll
        for (int i = 0; i < 8; ++i) v[i] = *(const f32x4*)(s + (size_t)(8 * i) * nsrc); }
    for (; it < nitems; it += NGW) {
        const int kb = it / nnb, nb = it - kb * nnb, k0 = kb * 64;
#pragma unroll
        for (int i = 0; i < 8; ++i) { const int k = k0 + kq + 8 * i; float gk = 1.f;
            if (kind == 1 || kind == 2) gk = kgain[k]; else if (kind == 3) gk = k < 1024 ? kgain[k & 127] * aux : 1.f;
            LAS float* w = scr + (kq + 8 * i) * 33 + 4 * n4; w[0] = v[i][0] * gk; w[1] = v[i][1] * gk; w[2] = v[i][2] * gk; w[3] = v[i][3] * gk; }
        const int itn = it + NGW;
        if (itn < nitems) { const int kbn = itn / nnb, nbn = itn - kbn * nnb; const float* s = conv_src(kind, W0, W1, nbn * 32 + 4 * n4) + (size_t)(kbn * 64 + kq) * nsrc;
#pragma unroll
            for (int i = 0; i < 8; ++i) v[i] = *(const f32x4*)(s + (size_t)(8 * i) * nsrc); }
        LDS_WAIT(); asm volatile("" ::: "memory");
#pragma unroll
        for (int j = 0; j < 4; ++j) { const int n = rn + 8 * j; const LAS float* r = scr + (8 * ch) * 33 + n;
            v4u o; o.x = pk2(r[0], r[33]); o.y = pk2(r[2 * 33], r[3 * 33]); o.z = pk2(r[4 * 33], r[5 * 33]); o.w = pk2(r[6 * 33], r[7 * 33]);
            *(v4u*)(WT + (size_t)(nb * 32 + n) * (K + 128) + k0 + 8 * ch) = o; }
        LDS_WAIT(); asm volatile("" ::: "memory");
    }
}
__device__ __forceinline__ void cb_row(const bf16* O, const bf16* proj, bf16* cat, bf16* catm, float lam, int row, int lane_in) {
    int lane = lane_in; asm volatile("" : "+v"(lane));
    if (row < MREAL) {
        const int h = lane >> 3, e0 = 16 * (lane & 7);
        const v4u* o1 = (const v4u*)(O + (size_t)row * D_ + (2 * h) * 128 + e0); const v4u* o2 = (const v4u*)(O + (size_t)row * D_ + (2 * h + 1) * 128 + e0);
        float d[16]; float ss = 0.f;
#pragma unroll
        for (int q = 0; q < 2; ++q) { const v4u a = o1[q], b = o2[q];
#pragma unroll
            for (int i = 0; i < 4; ++i) { d[8 * q + 2 * i] = bf_lo(a[i]) - lam * bf_lo(b[i]); d[8 * q + 2 * i + 1] = bf_hi(a[i]) - lam * bf_hi(b[i]); } }
#pragma unroll
        for (int i = 0; i < 16; ++i) ss += d[i] * d[i];
        ss += __shfl_xor(ss, 1); ss += __shfl_xor(ss, 2); ss += __shfl_xor(ss, 4);
        const float rn = 1.0f / sqrtf(ss * (1.0f / 128.0f) + SUBLN_EPS);
        v4u* op = (v4u*)(cat + (size_t)row * LDH + h * 128 + e0);
#pragma unroll
        for (int q = 0; q < 2; ++q) { v4u o; o.x = pk2(d[8 * q] * rn, d[8 * q + 1] * rn); o.y = pk2(d[8 * q + 2] * rn, d[8 * q + 3] * rn); o.z = pk2(d[8 * q + 4] * rn, d[8 * q + 5] * rn); o.w = pk2(d[8 * q + 6] * rn, d[8 * q + 7] * rn); op[q] = o; }
    }
    {
        int vrow, pos;
        if (row < MREAL) { const int b = row >> 11, t = row & 2047; vrow = b * VSEQ + 64 + t; pos = NMETA + t; } else { vrow = 48 + (row - MREAL); pos = row - MREAL; }
        const int w = 2 << (lane >> 4), cnt = (pos + 1) < w ? (pos + 1) : w;
        const bf16* zp = proj + (size_t)vrow * LDP + 3072 + 16 * lane;
        float acc[16], self[16];
#pragma unroll
        for (int i = 0; i < 16; ++i) acc[i] = 0.f;
        for (int s = 0; s < cnt; ++s) { const v4u* z = (const v4u*)(zp - (size_t)s * LDP);
#pragma unroll
            for (int q = 0; q < 2; ++q) { const v4u a = z[q];
#pragma unroll
                for (int i = 0; i < 4; ++i) { const float lo = bf_lo(a[i]), hi = bf_hi(a[i]); acc[8 * q + 2 * i] += lo; acc[8 * q + 2 * i + 1] += hi; if (s == 0) { self[8 * q + 2 * i] = lo; self[8 * q + 2 * i + 1] = hi; } } } }
        const float inv = 1.0f / (float)cnt;
        v4u* op = (v4u*)((row < MREAL ? cat + (size_t)row * LDH : catm + (size_t)(row - MREAL) * D_) + 1024 + 16 * lane);
#pragma unroll
        for (int q = 0; q < 2; ++q) { float y[8];
#pragma unroll
            for (int i = 0; i < 8; ++i) y[i] = acc[8 * q + i] * inv - self[8 * q + i];
            v4u o; o.x = pk2(y[0], y[1]); o.y = pk2(y[2], y[3]); o.z = pk2(y[4], y[5]); o.w = pk2(y[6], y[7]); op[q] = o; }
    }
}
__device__ __forceinline__ void cb_pool_item(const bf16* proj, bf16* cat, int item, int lane_in) {
    int lane = lane_in; asm volatile("" : "+v"(lane));
    const int half = item & 1, chunk = (item >> 1) & 63, b = item >> 7;
    const int c0 = 8 * (lane + 64 * half), w = 2 << (c0 >> 8);
    const bf16* zp = proj + (size_t)(b * VSEQ + 64 + 32 * chunk) * LDP + 3072 + c0;
    bf16* op = cat + (size_t)(b * NSEQ + 32 * chunk) * LDH + 1024 + c0;
    float S[8];
#pragma unroll
    for (int i = 0; i < 8; ++i) S[i] = 0.f;
    for (int s = 1; s <= w; ++s) { const v4u a = *(const v4u*)(zp - (long)s * LDP);
#pragma unroll
        for (int i = 0; i < 4; ++i) { S[2 * i] += bf_lo(a[i]); S[2 * i + 1] += bf_hi(a[i]); } }
    const float inv = 1.0f / (float)w;
#pragma unroll 1
    for (int t0 = 0; t0 < 32; t0 += 8) {
        v4u zn[8], zo[8];
#pragma unroll
        for (int t = 0; t < 8; ++t) { zn[t] = *(const v4u*)(zp + (long)(t0 + t) * LDP); zo[t] = *(const v4u*)(zp + (long)(t0 + t - w) * LDP); }
#pragma unroll
        for (int t = 0; t < 8; ++t) { float y[8];
#pragma unroll
            for (int i = 0; i < 4; ++i) { const float nl = bf_lo(zn[t][i]), nh = bf_hi(zn[t][i]);
                S[2 * i] += nl - bf_lo(zo[t][i]); S[2 * i + 1] += nh - bf_hi(zo[t][i]);
                y[2 * i] = S[2 * i] * inv - nl; y[2 * i + 1] = S[2 * i + 1] * inv - nh; }
            v4u o; o.x = pk2(y[0], y[1]); o.y = pk2(y[2], y[3]); o.z = pk2(y[4], y[5]); o.w = pk2(y[6], y[7]);
            *(v4u*)(op + (size_t)(t0 + t) * LDH) = o; }
    }
}
__device__ __forceinline__ void cb_combine8(const bf16* O, bf16* cat, float lam, int row0, int lane_in) {
    int lane = lane_in; asm volatile("" : "+v"(lane));
    const int h = lane >> 3, e0 = 16 * (lane & 7);
    const bf16* o1p = O + (size_t)row0 * D_ + (2 * h) * 128 + e0; bf16* cp = cat + (size_t)row0 * LDH + h * 128 + e0;
#pragma unroll 1
    for (int r0 = 0; r0 < 8; r0 += 4) {
        v4u a[4][2], bq[4][2];
#pragma unroll
        for (int r = 0; r < 4; ++r)
#pragma unroll
            for (int q = 0; q < 2; ++q) { a[r][q] = *((const v4u*)(o1p + (size_t)(r0 + r) * D_) + q); bq[r][q] = *((const v4u*)(o1p + (size_t)(r0 + r) * D_ + 128) + q); }
#pragma unroll
        for (int r = 0; r < 4; ++r) { float d[16]; float ss = 0.f;
#pragma unroll
            for (int q = 0; q < 2; ++q)
#pragma unroll
                for (int i = 0; i < 4; ++i) { d[8 * q + 2 * i] = bf_lo(a[r][q][i]) - lam * bf_lo(bq[r][q][i]); d[8 * q + 2 * i + 1] = bf_hi(a[r][q][i]) - lam * bf_hi(bq[r][q][i]); }
#pragma unroll
            for (int i = 0; i < 16; ++i) ss += d[i] * d[i];
            ss += __shfl_xor(ss, 1); ss += __shfl_xor(ss, 2); ss += __shfl_xor(ss, 4);
            const float rn = __builtin_amdgcn_rsqf(ss * (1.0f / 128.0f) + SUBLN_EPS);
            v4u* op = (v4u*)(cp + (size_t)(r0 + r) * LDH);
#pragma unroll
            for (int q = 0; q < 2; ++q) { v4u o; o.x = pk2(d[8 * q] * rn, d[8 * q + 1] * rn); o.y = pk2(d[8 * q + 2] * rn, d[8 * q + 3] * rn); o.z = pk2(d[8 * q + 4] * rn, d[8 * q + 5] * rn); o.w = pk2(d[8 * q + 6] * rn, d[8 * q + 7] * rn); op[q] = o; } }
    }
}
__device__ __forceinline__ void cb_meta_attn(const bf16* proj, bf16* catm, float lam, int h, int lane_in) {
    int lane = lane_in; asm volatile("" : "+v"(lane));
    const int q = lane & 15, eg = lane >> 4; const bf16* base = proj + (size_t)48 * LDP;
    float a[16];
#pragma unroll
    for (int k = 0; k < 16; ++k) a[k] = 0.f;
#pragma unroll 1
    for (int m = 0; m < 2; ++m) {
        const v4u* qp = (const v4u*)(base + (size_t)q * LDP + (2 * h + m) * 64);
        float s[16]; float mx = -INFINITY;
#pragma unroll
        for (int k = 0; k < 16; ++k) { const v4u* kp = (const v4u*)(base + (size_t)k * LDP + 1024 + (2 * h + m) * 64); float dsum = 0.f;
#pragma unroll
            for (int c = 0; c < 8; ++c) { const v4u w = kp[c], qw = qp[c];
#pragma unroll
                for (int i = 0; i < 4; ++i) dsum += bf_lo(qw[i]) * bf_lo(w[i]) + bf_hi(qw[i]) * bf_hi(w[i]); }
            s[k] = k <= q ? dsum : -INFINITY; mx = fmaxf(mx, s[k]); }
        float l = 0.f;
#pragma unroll
        for (int k = 0; k < 16; ++k) { s[k] = __builtin_amdgcn_exp2f(s[k] - mx); l += s[k]; }
        const float f = (m == 0 ? 1.0f : -lam) / l;
#pragma unroll
        for (int k = 0; k < 16; ++k) a[k] += f * s[k];
    }
    float o[32];
#pragma unroll
    for (int i = 0; i < 32; ++i) o[i] = 0.f;
#pragma unroll
    for (int k = 0; k < 16; ++k) { const v4u* vp = (const v4u*)(base + (size_t)k * LDP + 2048 + h * 128 + 32 * eg);
#pragma unroll
        for (int c = 0; c < 4; ++c) { const v4u w = vp[c];
#pragma unroll
            for (int i = 0; i < 4; ++i) { o[8 * c + 2 * i] += a[k] * bf_lo(w[i]); o[8 * c + 2 * i + 1] += a[k] * bf_hi(w[i]); } } }
    float ss = 0.f;
#pragma unroll
    for (int i = 0; i < 32; ++i) ss += o[i] * o[i];
    ss += __shfl_xor(ss, 16); ss += __shfl_xor(ss, 32);
    const float rn = 1.0f / sqrtf(ss * (1.0f / 128.0f) + SUBLN_EPS);
    v4u* op = (v4u*)(catm + (size_t)q * D_ + h * 128 + 32 * eg);
#pragma unroll
    for (int c = 0; c < 4; ++c) { v4u w; w.x = pk2(o[8 * c] * rn, o[8 * c + 1] * rn); w.y = pk2(o[8 * c + 2] * rn, o[8 * c + 3] * rn); w.z = pk2(o[8 * c + 4] * rn, o[8 * c + 5] * rn); w.w = pk2(o[8 * c + 6] * rn, o[8 * c + 7] * rn); op[c] = w; }
}
#ifndef PROBE
#define PROBE 0
#endif
#ifndef PROBE_A0
#define PROBE_A0 0
#define PROBE_A1 2
#define PROBE_B0 2
#define PROBE_B1 4
#endif
constexpr size_t WS_STAMP = 512 * 1024;
#ifndef REPEAT_MASK
#define REPEAT_MASK 0u
#endif
#define NREP(bit) (((REPEAT_MASK >> (bit)) & 1u) ? 2 : 1)
#ifndef PROBE_VAR
#define PROBE_VAR 0
#endif
namespace pg8 {
struct EpiSink { static constexpr bool PERM = true, AFTER_DRAIN = false; float* O;
    __device__ __forceinline__ void operator()(const f32x4 (&acc)[2][2][4][2], const Unit& u, int wr, int wc, int fr, int fq) const {
        f32x4 s = (f32x4){0.f, 0.f, 0.f, 0.f};
#pragma unroll
        for (int a = 0; a < 2; ++a)
#pragma unroll
            for (int b = 0; b < 2; ++b)
#pragma unroll
                for (int m = 0; m < 4; ++m)
#pragma unroll
                    for (int n = 0; n < 2; ++n) s = s + acc[a][b][m][n];
        const float t = (s[0] + s[1]) + (s[2] + s[3]);
        if (t == 1.2345e30f) O[u.pm + wr + wc + fr + fq] = t; } };
template <bool HOT> struct ProbeOrder : StaticOrder {
    __device__ bool next(int i, Unit& u) const { const bool r = StaticOrder::next(i, u); if (HOT) { u.pm = 0; u.pn = 0; } return r; } };
}
#ifndef WGM_RES
#define WGM_RES 4
#endif
#ifndef WGM_GU
#define WGM_GU 4
#endif
#ifndef WGM_IN
#define WGM_IN 4
#endif
#ifndef STAGGER
#define STAGGER 0
#endif
#ifndef MK_ONE_LAUNCH
#define MK_ONE_LAUNCH 1
#endif
typedef __attribute__((address_space(4))) const Args* KArgs;
__device__ __forceinline__ KArgs kargs() { KArgs p = (KArgs)__builtin_amdgcn_kernarg_segment_ptr(); asm volatile("" : "+s"(p)); return p; }
__global__ void __launch_bounds__(NWAVES * 64, 2) fwd_kernel(Args args_unused) {
    extern __shared__ __attribute__((aligned(16))) unsigned char lds[];
    Frame F;
    F.lds = (LAS unsigned char*)lds;
    F.MISC = (volatile LAS unsigned*)(F.lds + MISC_OFF);
    F.wave = __builtin_amdgcn_readfirstlane((int)threadIdx.x >> 6);
#define LANE() ({ int t_ = threadIdx.x; asm volatile("" : "+v"(t_)); t_ & 63; })
    F.G = gridDim.x; { const int bx = blockIdx.x; F.vcu = (F.G % 8 == 0) ? (bx % 8) * (F.G / 8) + bx / 8 : bx; }
    F.ctl = (gu32*)(kargs()->ws + WS_CTL);
    for (int u = threadIdx.x; u < (LDS_BYTES - LDSCTL_OFF) / 4; u += NWAVES * 64) ((LAS unsigned*)(F.lds + LDSCTL_OFF))[u] = 0u;
    __syncthreads();
    const int lo = kargs()->ph_lo, hi = kargs()->ph_hi;
    if (hi - lo > 1) (void)xcd_barrier_post((unsigned*)(F.ctl + CW_BAR), F.MISC + 8);
#ifndef PH_MASK
#define PH_MASK 0xFFFFFFFFu
#endif
#define EN(bit) ((PH_MASK >> (bit)) & 1u)
#define IN(k) (lo <= (k) && (k) < hi)
#define STAMP(i) do { if (PROBE && blockIdx.x == 0 && threadIdx.x == 0) ((unsigned long long*)(kargs()->ws + WS_STAMP))[(i)] = __builtin_amdgcn_s_memrealtime(); } while (0)
#define SEAM(k) do { STAMP(1 + 2 * (k)); if (IN(k) && IN((k) + 1)) { XcdBarrier bar_; bar_.bar = (unsigned*)(kargs()->ws + WS_CTL) + CW_BAR; bar_.x = xb_xcc_id(); bar_.st = F.MISC + 8; xcd_barrier(bar_); } STAMP(2 + 2 * (k)); } while (0)
#define WSP(T, off) ((T*)(A->ws + (off)))
    const int gw = F.vcu * NWAVES + F.wave, NGW = F.G * NWAVES;
    STAMP(0);

    _Pragma("unroll 1") for (int rp = 0; rp < NREP(0); ++rp) {
    if (EN(0) && IN(0)) { const KArgs A = kargs(); const int lane = LANE(); float* RC = WSP(float, WS_ROPE); float* RS = RC + NPOS * 32;
        for (int it = gw; it < 4096; it += NGW) fold_item(A->in[7], A->in[13], A->in[14], A->in[6], (bf16*)(A->ws + WS_WTS + (size_t)(it >> 10) * WL_BYTES + WL_IN), it, lane);
        for (int r = gw; r < MREAL; r += NGW) hinit_row(A->in[0], A->in[1], WSP(bf16, WS_HB), H16_MASTER ? WSP(bf16, WS_H16) : nullptr, WSP(float, WS_SSQ), r, lane);
        for (int j = gw; j < NMETA; j += NGW) hinit_meta(A->in[1], WSP(bf16, WS_HM), H16_MASTER ? WSP(bf16, WS_HM16) : nullptr, WSP(float, WS_SSQM), j, lane);
        for (int i = gw * 64 + lane; i < NPOS * 32; i += NGW * 64) { const int pos = i >> 5, f = i & 31;
            const float inv = 1.0f / powf(10000.0f, (float)(2 * f) / 64.0f); const float ang = (float)pos * inv; RC[i] = cosf(ang); RS[i] = sinf(ang); }
    }
    STAMP(1); STAMP(2); }
    _Pragma("unroll 1") for (int rp = 0; rp < NREP(1); ++rp) {
    if (EN(1) && IN(1)) { const KArgs A = kargs(); const int lane = LANE(); unsigned char* ws = A->ws;
        LAS float* scr = (LAS float*)(F.lds + RING_OFF) + F.wave * (64 * 33);
#pragma unroll 1
        for (int L = 0; L < DEPTH; ++L) { unsigned char* wl = ws + WS_WTS + (size_t)L * WL_BYTES; const size_t oFF = (size_t)L * D_ * FF_;
            conv_run(1, A->in[3] + oFF, A->in[4] + oFF, A->in[2] + L * D_, 0.f, (bf16*)(wl + WL_GU1), D_, FF_, 2 * FF_ / 32, (2 * FF_ / 32) * (D_ / 64), gw, NGW, lane, scr);
            conv_run(0, A->in[5] + oFF, nullptr, nullptr, 0.f, (bf16*)(wl + WL_D1), FF_, D_, D_ / 32, (D_ / 32) * (FF_ / 64), gw, NGW, lane, scr);
            conv_run(2, A->in[7] + (size_t)L * D_ * INW, nullptr, A->in[6] + L * D_, 0.f, (bf16*)(wl + WL_IN), D_, INW, 3072 / 32, (3072 / 32) * (D_ / 64), gw, NGW, lane, scr);
            conv_run(3, A->in[15] + (size_t)L * D_ * D_, nullptr, A->in[12] + L * 128, 1.0f - A->lam_init[L], (bf16*)(wl + WL_OUT), D_, D_, D_ / 32, (D_ / 32) * (D_ / 64), gw, NGW, lane, scr);
            conv_run(1, A->in[17] + oFF, A->in[18] + oFF, A->in[16] + L * D_, 0.f, (bf16*)(wl + WL_GU2), D_, FF_, 2 * FF_ / 32, (2 * FF_ / 32) * (D_ / 64), gw, NGW, lane, scr);
            conv_run(0, A->in[19] + oFF, nullptr, nullptr, 0.f, (bf16*)(wl + WL_D2), FF_, D_, D_ / 32, (D_ / 32) * (FF_ / 64), gw, NGW, lane, scr);
        }
    }
    SEAM(1); }
#define LAYER() const int L = Lc
#define WL(off) ((const bf16*)(A->ws + WS_WTS + (size_t)L * WL_BYTES + (off)))
#define SSQ(k) ((float*)(A->ws + WS_SSQ + (size_t)(3 * L + (k)) * SSQ_SET))
#define SSQM(k) ((float*)(A->ws + WS_SSQM + (size_t)(3 * L + (k)) * SSQM_SET))
#define THIN_ARGS F.vcu, F.G, F.wave, LANE(), (LAS float*)(F.lds + RING_OFF)
    { constexpr int Lc = 0;
        const int pb = 2 + 8 * Lc;
        _Pragma("unroll 1") for (int rp = 0; rp < NREP(2); ++rp) {
        if (EN(2) && IN(pb + 0)) { const KArgs A = kargs(); LAYER(); if (!rp) thin_gu<!H16_MASTER>(WSP(bf16, WS_HM), WL(WL_GU1), SSQM(0), WSP(bf16, WS_MIDM), THIN_ARGS); pg8::Gemm g{WSP(bf16, WS_HB), WL(WL_GU1), MREAL, 2 * FF_, D_, LDH, LDH}; pg8::StaticOrder S; S.init(MREAL, 2 * FF_, F.G, (int)blockIdx.x, WGM_GU);
#if PROBE_VAR >= 6
            if (rp) { pg8::EpiSwiGLUT<PROBE_VAR> E2{WSP(bf16, WS_MID), SSQ(0)}; pg8::gemm_phase<pg8::EpiSwiGLUT<PROBE_VAR>, pg8::StaticOrder, true, true, !H16_MASTER>(F.lds + RING_OFF, g, S, E2); } else
#elif PROBE_VAR == 1 || PROBE_VAR == 2
            if (rp) { pg8::ProbeOrder<PROBE_VAR == 2> S2; S2.init(MREAL, 2 * FF_, F.G, (int)blockIdx.x); pg8::EpiSink E2{WSP(float, WS_SSQ)}; pg8::gemm_phase<pg8::EpiSink, pg8::ProbeOrder<PROBE_VAR == 2>, true, true, !H16_MASTER>(F.lds + RING_OFF, g, S2, E2); } else
#endif
            { pg8::EpiSwiGLU E{WSP(bf16, WS_MID), SSQ(0)}; pg8::gemm_phase<pg8::EpiSwiGLU, pg8::StaticOrder, true, true, !H16_MASTER>(F.lds + RING_OFF, g, S, E); } }
        SEAM(pb + 0); }
        _Pragma("unroll 1") for (int rp = 0; rp < NREP(3); ++rp) {
        if (EN(3) && IN(pb + 1)) { const KArgs A = kargs(); LAYER(); if (!rp) thin_resid<22>(WSP(bf16, WS_MIDM), WL(WL_D1), FF_, WSP(bf16, WS_HM), H16_MASTER ? WSP(bf16, WS_HM16) : nullptr, SSQM(1), 0.5f, THIN_ARGS); pg8::Gemm g{WSP(bf16, WS_MID), WL(WL_D1), MREAL, D_, FF_, LDM, LDM}; pg8::StaggerOrder S; S.init2(MREAL, D_, FF_, F.G, (int)blockIdx.x, STAGGER ? (int)((blockIdx.x >> 3) & 3) : 0, WGM_RES);
#if PROBE_VAR >= 3 && PROBE_VAR <= 5
            if (rp) { pg8::EpiResidT<PROBE_VAR> E2{WSP(bf16, WS_HB), SSQ(1), 0.f, F.lds + XR_OFF, (bf16*)A->out, H16_MASTER ? WSP(bf16, WS_H16) : nullptr}; pg8::gemm_phase<pg8::EpiResidT<PROBE_VAR>, pg8::StaggerOrder, true, true>(F.lds + RING_OFF, g, S, E2); } else
#elif PROBE_VAR
            if (rp) { pg8::ProbeOrder<PROBE_VAR == 2> S2; S2.init(MREAL, D_, F.G, (int)blockIdx.x); pg8::EpiSink E2{WSP(float, WS_SSQ)}; pg8::gemm_phase<pg8::EpiSink, pg8::ProbeOrder<PROBE_VAR == 2>, true, true>(F.lds + RING_OFF, g, S2, E2); } else
#endif
            { pg8::EpiResid E{WSP(bf16, WS_HB), SSQ(1), rp ? 0.f : 0.5f, F.lds + XR_OFF, nullptr, H16_MASTER ? WSP(bf16, WS_H16) : nullptr}; pg8::gemm_phase<pg8::EpiResid, pg8::StaggerOrder, true, true>(F.lds + RING_OFF, g, S, E); } }
        SEAM(pb + 1); }
        _Pragma("unroll 1") for (int rp = 0; rp < NREP(4); ++rp) {
        if (EN(4) && IN(pb + 2)) { const KArgs A = kargs(); LAYER(); if (!rp) thin_proj<!H16_MASTER>(WSP(bf16, WS_HM), WL(WL_IN), SSQM(1), WSP(bf16, WS_PROJ), WSP(float, WS_ROPE), WSP(float, WS_ROPE) + NPOS * 32, THIN_ARGS); pg8::Gemm g{WSP(bf16, WS_HB), WL(WL_IN), MREAL, INW, D_, LDH, LDH}; pg8::StaticOrder S; S.init(MREAL, INW, F.G, (int)blockIdx.x, WGM_IN);
            pg8::EpiProj E{WSP(bf16, WS_PROJ), SSQ(1), WSP(float, WS_ROPE), WSP(float, WS_ROPE) + NPOS * 32}; pg8::gemm_phase<pg8::EpiProj, pg8::StaticOrder, true, true, !H16_MASTER>(F.lds + RING_OFF, g, S, E); }
        SEAM(pb + 2); }
        _Pragma("unroll 1") for (int rp = 0; rp < NREP(5); ++rp) {
        if (EN(5) && IN(pb + 3)) { const KArgs A = kargs(); LAYER(); const bf16* PROJ = WSP(bf16, WS_PROJ); bf16* CAT = WSP(bf16, WS_CAT);
            const int ln_ = LANE(); const float sa = wave_sum(A->in[8][L * 64 + ln_] * A->in[9][L * 64 + ln_]), sb = wave_sum(A->in[10][L * 64 + ln_] * A->in[11][L * 64 + ln_]);
            const float lam = expf(sa) - expf(sb) + A->lam_init[L];
            for (int v = F.vcu; v < 256; v += F.G) { const int bh = v >> 1, sx = v & 1, b = bh >> 3, h = bh & 7;
#pragma unroll 1
                for (int i = 0; i < 8; ++i) { const int m = i & 1, qs = i >> 1;
                    const int qb = sx == 0 ? (qs == 0 ? 0 : qs == 1 ? 7 : qs == 2 ? 1 : 6) : (qs == 0 ? 2 : qs == 1 ? 5 : qs == 2 ? 3 : 4);
                    const attn_body::bf16* P = (const attn_body::bf16*)PROJ + (size_t)b * VSEQ * LDP;
                    attn_body::attn_unit<8>(qb, P + (size_t)(64 + 256 * qb) * LDP + (2 * h + m) * 64, P + 1024 + (2 * h + m) * 64, P + 2048 + h * 128,
                                            (attn_body::bf16*)CAT + (size_t)(b * NSEQ + 256 * qb) * LDH + h * 128, (char*)lds + RING_OFF, m, lam, (float*)(A->ws + WS_OSCR) + (size_t)v * 32768); } }
            { bf16* CATM = WSP(bf16, WS_CATM); const int lane = LANE();
              if (gw < NHEADS && NGW > 64) cb_meta_attn(PROJ, CATM, lam, gw, lane);
              else { const int w0 = NGW > 64 ? gw - NHEADS : gw, nw = NGW > 64 ? NGW - NHEADS : NGW;
                if (NGW <= 64) for (int it = gw; it < NHEADS; it += NGW) cb_meta_attn(PROJ, CATM, lam, it, lane);
                for (int it = w0; it < NMETA + NBATCH * 128; it += nw) {
                    if (it < NMETA) cb_row((const bf16*)nullptr, PROJ, CAT, CATM, lam, MREAL + it, lane);
                    else cb_pool_item(PROJ, CAT, it - NMETA, lane); } } }
        }
        SEAM(pb + 3); }
        _Pragma("unroll 1") for (int rp = 0; rp < NREP(7); ++rp) {
        if (EN(7) && IN(pb + 5)) { const KArgs A = kargs(); LAYER(); if (!rp) thin_resid<8>(WSP(bf16, WS_CATM), WL(WL_OUT), D_, WSP(bf16, WS_HM), H16_MASTER ? WSP(bf16, WS_HM16) : nullptr, SSQM(2), 1.0f, THIN_ARGS); pg8::Gemm g{WSP(bf16, WS_CAT), WL(WL_OUT), MREAL, D_, D_, LDH, LDH}; pg8::StaggerOrder S; S.init2(MREAL, D_, D_, F.G, (int)blockIdx.x, STAGGER ? (int)((blockIdx.x >> 3) & 3) : 0, WGM_RES);
            pg8::EpiResid E{WSP(bf16, WS_HB), SSQ(2), rp ? 0.f : 1.0f, F.lds + XR_OFF, nullptr, H16_MASTER ? WSP(bf16, WS_H16) : nullptr}; pg8::gemm_phase<pg8::EpiResid, pg8::StaggerOrder, true, true>(F.lds + RING_OFF, g, S, E); }
        SEAM(pb + 5); }
        _Pragma("unroll 1") for (int rp = 0; rp < NREP(8); ++rp) {
        if (EN(8) && IN(pb + 6)) { const KArgs A = kargs(); LAYER(); if (!rp) thin_gu<!H16_MASTER>(WSP(bf16, WS_HM), WL(WL_GU2), SSQM(2), WSP(bf16, WS_MIDM), THIN_ARGS); pg8::Gemm g{WSP(bf16, WS_HB), WL(WL_GU2), MREAL, 2 * FF_, D_, LDH, LDH}; pg8::StaticOrder S; S.init(MREAL, 2 * FF_, F.G, (int)blockIdx.x, WGM_GU);
            pg8::EpiSwiGLU E{WSP(bf16, WS_MID), SSQ(2)}; pg8::gemm_phase<pg8::EpiSwiGLU, pg8::StaticOrder, true, true, !H16_MASTER>(F.lds + RING_OFF, g, S, E); }
        SEAM(pb + 6); }
        _Pragma("unroll 1") for (int rp = 0; rp < NREP(9); ++rp) {
        if (EN(9) && IN(pb + 7)) { const KArgs A = kargs(); LAYER(); if (!rp) thin_resid<22>(WSP(bf16, WS_MIDM), WL(WL_D2), FF_, WSP(bf16, WS_HM), H16_MASTER ? WSP(bf16, WS_HM16) : nullptr, SSQM(3), 0.5f, THIN_ARGS); pg8::Gemm g{WSP(bf16, WS_MID), WL(WL_D2), MREAL, D_, FF_, LDM, LDM}; pg8::StaggerOrder S; S.init2(MREAL, D_, FF_, F.G, (int)blockIdx.x, STAGGER ? (int)((blockIdx.x >> 3) & 3) : 0, WGM_RES);
            pg8::EpiResid E{WSP(bf16, WS_HB), SSQ(3), rp ? 0.f : 0.5f, F.lds + XR_OFF, nullptr, H16_MASTER ? WSP(bf16, WS_H16) : nullptr}; pg8::gemm_phase<pg8::EpiResid, pg8::StaggerOrder, true, true>(F.lds + RING_OFF, g, S, E); }
        SEAM(pb + 7); }
    }
    { constexpr int Lc = 1;
        const int pb = 2 + 8 * Lc;
        _Pragma("unroll 1") for (int rp = 0; rp < NREP(2); ++rp) {
        if (EN(2) && IN(pb + 0)) { const KArgs A = kargs(); LAYER(); if (!rp) thin_gu<!H16_MASTER>(WSP(bf16, WS_HM), WL(WL_GU1), SSQM(0), WSP(bf16, WS_MIDM), THIN_ARGS); pg8::Gemm g{WSP(bf16, WS_HB), WL(WL_GU1), MREAL, 2 * FF_, D_, LDH, LDH}; pg8::StaticOrder S; S.init(MREAL, 2 * FF_, F.G, (int)blockIdx.x, WGM_GU);
#if PROBE_VAR >= 6
            if (rp) { pg8::EpiSwiGLUT<PROBE_VAR> E2{WSP(bf16, WS_MID), SSQ(0)}; pg8::gemm_phase<pg8::EpiSwiGLUT<PROBE_VAR>, pg8::StaticOrder, true, true, !H16_MASTER>(F.lds + RING_OFF, g, S, E2); } else
#elif PROBE_VAR == 1 || PROBE_VAR == 2
            if (rp) { pg8::ProbeOrder<PROBE_VAR == 2> S2; S2.init(MREAL, 2 * FF_, F.G, (int)blockIdx.x); pg8::EpiSink E2{WSP(float, WS_SSQ)}; pg8::gemm_phase<pg8::EpiSink, pg8::ProbeOrder<PROBE_VAR == 2>, true, true, !H16_MASTER>(F.lds + RING_OFF, g, S2, E2); } else
#endif
            { pg8::EpiSwiGLU E{WSP(bf16, WS_MID), SSQ(0)}; pg8::gemm_phase<pg8::EpiSwiGLU, pg8::StaticOrder, true, true, !H16_MASTER>(F.lds + RING_OFF, g, S, E); } }
        SEAM(pb + 0); }
        _Pragma("unroll 1") for (int rp = 0; rp < NREP(3); ++rp) {
        if (EN(3) && IN(pb + 1)) { const KArgs A = kargs(); LAYER(); if (!rp) thin_resid<22>(WSP(bf16, WS_MIDM), WL(WL_D1), FF_, WSP(bf16, WS_HM), H16_MASTER ? WSP(bf16, WS_HM16) : nullptr, SSQM(1), 0.5f, THIN_ARGS); pg8::Gemm g{WSP(bf16, WS_MID), WL(WL_D1), MREAL, D_, FF_, LDM, LDM}; pg8::StaggerOrder S; S.init2(MREAL, D_, FF_, F.G, (int)blockIdx.x, STAGGER ? (int)((blockIdx.x >> 3) & 3) : 0, WGM_RES);
#if PROBE_VAR >= 3 && PROBE_VAR <= 5
            if (rp) { pg8::EpiResidT<PROBE_VAR> E2{WSP(bf16, WS_HB), SSQ(1), 0.f, F.lds + XR_OFF, (bf16*)A->out, H16_MASTER ? WSP(bf16, WS_H16) : nullptr}; pg8::gemm_phase<pg8::EpiResidT<PROBE_VAR>, pg8::StaggerOrder, true, true>(F.lds + RING_OFF, g, S, E2); } else
#elif PROBE_VAR
            if (rp) { pg8::ProbeOrder<PROBE_VAR == 2> S2; S2.init(MREAL, D_, F.G, (int)blockIdx.x); pg8::EpiSink E2{WSP(float, WS_SSQ)}; pg8::gemm_phase<pg8::EpiSink, pg8::ProbeOrder<PROBE_VAR == 2>, true, true>(F.lds + RING_OFF, g, S2, E2); } else
#endif
            { pg8::EpiResid E{WSP(bf16, WS_HB), SSQ(1), rp ? 0.f : 0.5f, F.lds + XR_OFF, nullptr, H16_MASTER ? WSP(bf16, WS_H16) : nullptr}; pg8::gemm_phase<pg8::EpiResid, pg8::StaggerOrder, true, true>(F.lds + RING_OFF, g, S, E); } }
        SEAM(pb + 1); }
        _Pragma("unroll 1") for (int rp = 0; rp < NREP(4); ++rp) {
        if (EN(4) && IN(pb + 2)) { const KArgs A = kargs(); LAYER(); if (!rp) thin_proj<!H16_MASTER>(WSP(bf16, WS_HM), WL(WL_IN), SSQM(1), WSP(bf16, WS_PROJ), WSP(float, WS_ROPE), WSP(float, WS_ROPE) + NPOS * 32, THIN_ARGS); pg8::Gemm g{WSP(bf16, WS_HB), WL(WL_IN), MREAL, INW, D_, LDH, LDH}; pg8::StaticOrder S; S.init(MREAL, INW, F.G, (int)blockIdx.x, WGM_IN);
            pg8::EpiProj E{WSP(bf16, WS_PROJ), SSQ(1), WSP(float, WS_ROPE), WSP(float, WS_ROPE) + NPOS * 32}; pg8::gemm_phase<pg8::EpiProj, pg8::StaticOrder, true, true, !H16_MASTER>(F.lds + RING_OFF, g, S, E); }
        SEAM(pb + 2); }
        _Pragma("unroll 1") for (int rp = 0; rp < NREP(5); ++rp) {
        if (EN(5) && IN(pb + 3)) { const KArgs A = kargs(); LAYER(); const bf16* PROJ = WSP(bf16, WS_PROJ); bf16* CAT = WSP(bf16, WS_CAT);
            const int ln_ = LANE(); const float sa = wave_sum(A->in[8][L * 64 + ln_] * A->in[9][L * 64 + ln_]), sb = wave_sum(A->in[10][L * 64 + ln_] * A->in[11][L * 64 + ln_]);
            const float lam = expf(sa) - expf(sb) + A->lam_init[L];
            for (int v = F.vcu; v < 256; v += F.G) { const int bh = v >> 1, sx = v & 1, b = bh >> 3, h = bh & 7;
#pragma unroll 1
                for (int i = 0; i < 8; ++i) { const int m = i & 1, qs = i >> 1;
                    const int qb = sx == 0 ? (qs == 0 ? 0 : qs == 1 ? 7 : qs == 2 ? 1 : 6) : (qs == 0 ? 2 : qs == 1 ? 5 : qs == 2 ? 3 : 4);
                    const attn_body::bf16* P = (const attn_body::bf16*)PROJ + (size_t)b * VSEQ * LDP;
                    attn_body::attn_unit<8>(qb, P + (size_t)(64 + 256 * qb) * LDP + (2 * h + m) * 64, P + 1024 + (2 * h + m) * 64, P + 2048 + h * 128,
                                            (attn_body::bf16*)CAT + (size_t)(b * NSEQ + 256 * qb) * LDH + h * 128, (char*)lds + RING_OFF, m, lam, (float*)(A->ws + WS_OSCR) + (size_t)v * 32768); } }
            { bf16* CATM = WSP(bf16, WS_CATM); const int lane = LANE();
              if (gw < NHEADS && NGW > 64) cb_meta_attn(PROJ, CATM, lam, gw, lane);
              else { const int w0 = NGW > 64 ? gw - NHEADS : gw, nw = NGW > 64 ? NGW - NHEADS : NGW;
                if (NGW <= 64) for (int it = gw; it < NHEADS; it += NGW) cb_meta_attn(PROJ, CATM, lam, it, lane);
                for (int it = w0; it < NMETA + NBATCH * 128; it += nw) {
                    if (it < NMETA) cb_row((const bf16*)nullptr, PROJ, CAT, CATM, lam, MREAL + it, lane);
                    else cb_pool_item(PROJ, CAT, it - NMETA, lane); } } }
        }
        SEAM(pb + 3); }
        _Pragma("unroll 1") for (int rp = 0; rp < NREP(7); ++rp) {
        if (EN(7) && IN(pb + 5)) { const KArgs A = kargs(); LAYER(); if (!rp) thin_resid<8>(WSP(bf16, WS_CATM), WL(WL_OUT), D_, WSP(bf16, WS_HM), H16_MASTER ? WSP(bf16, WS_HM16) : nullptr, SSQM(2), 1.0f, THIN_ARGS); pg8::Gemm g{WSP(bf16, WS_CAT), WL(WL_OUT), MREAL, D_, D_, LDH, LDH}; pg8::StaggerOrder S; S.init2(MREAL, D_, D_, F.G, (int)blockIdx.x, STAGGER ? (int)((blockIdx.x >> 3) & 3) : 0, WGM_RES);
            pg8::EpiResid E{WSP(bf16, WS_HB), SSQ(2), rp ? 0.f : 1.0f, F.lds + XR_OFF, nullptr, H16_MASTER ? WSP(bf16, WS_H16) : nullptr}; pg8::gemm_phase<pg8::EpiResid, pg8::StaggerOrder, true, true>(F.lds + RING_OFF, g, S, E); }
        SEAM(pb + 5); }
        _Pragma("unroll 1") for (int rp = 0; rp < NREP(8); ++rp) {
        if (EN(8) && IN(pb + 6)) { const KArgs A = kargs(); LAYER(); if (!rp) thin_gu<!H16_MASTER>(WSP(bf16, WS_HM), WL(WL_GU2), SSQM(2), WSP(bf16, WS_MIDM), THIN_ARGS); pg8::Gemm g{WSP(bf16, WS_HB), WL(WL_GU2), MREAL, 2 * FF_, D_, LDH, LDH}; pg8::StaticOrder S; S.init(MREAL, 2 * FF_, F.G, (int)blockIdx.x, WGM_GU);
            pg8::EpiSwiGLU E{WSP(bf16, WS_MID), SSQ(2)}; pg8::gemm_phase<pg8::EpiSwiGLU, pg8::StaticOrder, true, true, !H16_MASTER>(F.lds + RING_OFF, g, S, E); }
        SEAM(pb + 6); }
        _Pragma("unroll 1") for (int rp = 0; rp < NREP(9); ++rp) {
        if (EN(9) && IN(pb + 7)) { const KArgs A = kargs(); LAYER(); if (!rp) thin_resid<22>(WSP(bf16, WS_MIDM), WL(WL_D2), FF_, WSP(bf16, WS_HM), H16_MASTER ? WSP(bf16, WS_HM16) : nullptr, SSQM(3), 0.5f, THIN_ARGS); pg8::Gemm g{WSP(bf16, WS_MID), WL(WL_D2), MREAL, D_, FF_, LDM, LDM}; pg8::StaggerOrder S; S.init2(MREAL, D_, FF_, F.G, (int)blockIdx.x, STAGGER ? (int)((blockIdx.x >> 3) & 3) : 0, WGM_RES);
            pg8::EpiResid E{WSP(bf16, WS_HB), SSQ(3), rp ? 0.f : 0.5f, F.lds + XR_OFF, nullptr, H16_MASTER ? WSP(bf16, WS_H16) : nullptr}; pg8::gemm_phase<pg8::EpiResid, pg8::StaggerOrder, true, true>(F.lds + RING_OFF, g, S, E); }
        SEAM(pb + 7); }
    }
    { constexpr int Lc = 2;
        const int pb = 2 + 8 * Lc;
        _Pragma("unroll 1") for (int rp = 0; rp < NREP(2); ++rp) {
        if (EN(2) && IN(pb + 0)) { const KArgs A = kargs(); LAYER(); if (!rp) thin_gu<!H16_MASTER>(WSP(bf16, WS_HM), WL(WL_GU1), SSQM(0), WSP(bf16, WS_MIDM), THIN_ARGS); pg8::Gemm g{WSP(bf16, WS_HB), WL(WL_GU1), MREAL, 2 * FF_, D_, LDH, LDH}; pg8::StaticOrder S; S.init(MREAL, 2 * FF_, F.G, (int)blockIdx.x, WGM_GU);
#if PROBE_VAR >= 6
            if (rp) { pg8::EpiSwiGLUT<PROBE_VAR> E2{WSP(bf16, WS_MID), SSQ(0)}; pg8::gemm_phase<pg8::EpiSwiGLUT<PROBE_VAR>, pg8::StaticOrder, true, true, !H16_MASTER>(F.lds + RING_OFF, g, S, E2); } else
#elif PROBE_VAR == 1 || PROBE_VAR == 2
            if (rp) { pg8::ProbeOrder<PROBE_VAR == 2> S2; S2.init(MREAL, 2 * FF_, F.G, (int)blockIdx.x); pg8::EpiSink E2{WSP(float, WS_SSQ)}; pg8::gemm_phase<pg8::EpiSink, pg8::ProbeOrder<PROBE_VAR == 2>, true, true, !H16_MASTER>(F.lds + RING_OFF, g, S2, E2); } else
#endif
            { pg8::EpiSwiGLU E{WSP(bf16, WS_MID), SSQ(0)}; pg8::gemm_phase<pg8::EpiSwiGLU, pg8::StaticOrder, true, true, !H16_MASTER>(F.lds + RING_OFF, g, S, E); } }
        SEAM(pb + 0); }
        _Pragma("unroll 1") for (int rp = 0; rp < NREP(3); ++rp) {
        if (EN(3) && IN(pb + 1)) { const KArgs A = kargs(); LAYER(); if (!rp) thin_resid<22>(WSP(bf16, WS_MIDM), WL(WL_D1), FF_, WSP(bf16, WS_HM), H16_MASTER ? WSP(bf16, WS_HM16) : nullptr, SSQM(1), 0.5f, THIN_ARGS); pg8::Gemm g{WSP(bf16, WS_MID), WL(WL_D1), MREAL, D_, FF_, LDM, LDM}; pg8::StaggerOrder S; S.init2(MREAL, D_, FF_, F.G, (int)blockIdx.x, STAGGER ? (int)((blockIdx.x >> 3) & 3) : 0, WGM_RES);
#if PROBE_VAR >= 3 && PROBE_VAR <= 5
            if (rp) { pg8::EpiResidT<PROBE_VAR> E2{WSP(bf16, WS_HB), SSQ(1), 0.f, F.lds + XR_OFF, (bf16*)A->out, H16_MASTER ? WSP(bf16, WS_H16) : nullptr}; pg8::gemm_phase<pg8::EpiResidT<PROBE_VAR>, pg8::StaggerOrder, true, true>(F.lds + RING_OFF, g, S, E2); } else
#elif PROBE_VAR
            if (rp) { pg8::ProbeOrder<PROBE_VAR == 2> S2; S2.init(MREAL, D_, F.G, (int)blockIdx.x); pg8::EpiSink E2{WSP(float, WS_SSQ)}; pg8::gemm_phase<pg8::EpiSink, pg8::ProbeOrder<PROBE_VAR == 2>, true, true>(F.lds + RING_OFF, g, S2, E2); } else
#endif
            { pg8::EpiResid E{WSP(bf16, WS_HB), SSQ(1), rp ? 0.f : 0.5f, F.lds + XR_OFF, nullptr, H16_MASTER ? WSP(bf16, WS_H16) : nullptr}; pg8::gemm_phase<pg8::EpiResid, pg8::StaggerOrder, true, true>(F.lds + RING_OFF, g, S, E); } }
        SEAM(pb + 1); }
        _Pragma("unroll 1") for (int rp = 0; rp < NREP(4); ++rp) {
        if (EN(4) && IN(pb + 2)) { const KArgs A = kargs(); LAYER(); if (!rp) thin_proj<!H16_MASTER>(WSP(bf16, WS_HM), WL(WL_IN), SSQM(1), WSP(bf16, WS_PROJ), WSP(float, WS_ROPE), WSP(float, WS_ROPE) + NPOS * 32, THIN_ARGS); pg8::Gemm g{WSP(bf16, WS_HB), WL(WL_IN), MREAL, INW, D_, LDH, LDH}; pg8::StaticOrder S; S.init(MREAL, INW, F.G, (int)blockIdx.x, WGM_IN);
            pg8::EpiProj E{WSP(bf16, WS_PROJ), SSQ(1), WSP(float, WS_ROPE), WSP(float, WS_ROPE) + NPOS * 32}; pg8::gemm_phase<pg8::EpiProj, pg8::StaticOrder, true, true, !H16_MASTER>(F.lds + RING_OFF, g, S, E); }
        SEAM(pb + 2); }
        _Pragma("unroll 1") for (int rp = 0; rp < NREP(5); ++rp) {
        if (EN(5) && IN(pb + 3)) { const KArgs A = kargs(); LAYER(); const bf16* PROJ = WSP(bf16, WS_PROJ); bf16* CAT = WSP(bf16, WS_CAT);
            const int ln_ = LANE(); const float sa = wave_sum(A->in[8][L * 64 + ln_] * A->in[9][L * 64 + ln_]), sb = wave_sum(A->in[10][L * 64 + ln_] * A->in[11][L * 64 + ln_]);
            const float lam = expf(sa) - expf(sb) + A->lam_init[L];
            for (int v = F.vcu; v < 256; v += F.G) { const int bh = v >> 1, sx = v & 1, b = bh >> 3, h = bh & 7;
#pragma unroll 1
                for (int i = 0; i < 8; ++i) { const int m = i & 1, qs = i >> 1;
                    const int qb = sx == 0 ? (qs == 0 ? 0 : qs == 1 ? 7 : qs == 2 ? 1 : 6) : (qs == 0 ? 2 : qs == 1 ? 5 : qs == 2 ? 3 : 4);
                    const attn_body::bf16* P = (const attn_body::bf16*)PROJ + (size_t)b * VSEQ * LDP;
                    attn_body::attn_unit<8>(qb, P + (size_t)(64 + 256 * qb) * LDP + (2 * h + m) * 64, P + 1024 + (2 * h + m) * 64, P + 2048 + h * 128,
                                            (attn_body::bf16*)CAT + (size_t)(b * NSEQ + 256 * qb) * LDH + h * 128, (char*)lds + RING_OFF, m, lam, (float*)(A->ws + WS_OSCR) + (size_t)v * 32768); } }
            { bf16* CATM = WSP(bf16, WS_CATM); const int lane = LANE();
              if (gw < NHEADS && NGW > 64) cb_meta_attn(PROJ, CATM, lam, gw, lane);
              else { const int w0 = NGW > 64 ? gw - NHEADS : gw, nw = NGW > 64 ? NGW - NHEADS : NGW;
                if (NGW <= 64) for (int it = gw; it < NHEADS; it += NGW) cb_meta_attn(PROJ, CATM, lam, it, lane);
                for (int it = w0; it < NMETA + NBATCH * 128; it += nw) {
                    if (it < NMETA) cb_row((const bf16*)nullptr, PROJ, CAT, CATM, lam, MREAL + it, lane);
                    else cb_pool_item(PROJ, CAT, it - NMETA, lane); } } }
        }
        SEAM(pb + 3); }
        _Pragma("unroll 1") for (int rp = 0; rp < NREP(7); ++rp) {
        if (EN(7) && IN(pb + 5)) { const KArgs A = kargs(); LAYER(); if (!rp) thin_resid<8>(WSP(bf16, WS_CATM), WL(WL_OUT), D_, WSP(bf16, WS_HM), H16_MASTER ? WSP(bf16, WS_HM16) : nullptr, SSQM(2), 1.0f, THIN_ARGS); pg8::Gemm g{WSP(bf16, WS_CAT), WL(WL_OUT), MREAL, D_, D_, LDH, LDH}; pg8::StaggerOrder S; S.init2(MREAL, D_, D_, F.G, (int)blockIdx.x, STAGGER ? (int)((blockIdx.x >> 3) & 3) : 0, WGM_RES);
            pg8::EpiResid E{WSP(bf16, WS_HB), SSQ(2), rp ? 0.f : 1.0f, F.lds + XR_OFF, nullptr, H16_MASTER ? WSP(bf16, WS_H16) : nullptr}; pg8::gemm_phase<pg8::EpiResid, pg8::StaggerOrder, true, true>(F.lds + RING_OFF, g, S, E); }
        SEAM(pb + 5); }
        _Pragma("unroll 1") for (int rp = 0; rp < NREP(8); ++rp) {
        if (EN(8) && IN(pb + 6)) { const KArgs A = kargs(); LAYER(); if (!rp) thin_gu<!H16_MASTER>(WSP(bf16, WS_HM), WL(WL_GU2), SSQM(2), WSP(bf16, WS_MIDM), THIN_ARGS); pg8::Gemm g{WSP(bf16, WS_HB), WL(WL_GU2), MREAL, 2 * FF_, D_, LDH, LDH}; pg8::StaticOrder S; S.init(MREAL, 2 * FF_, F.G, (int)blockIdx.x, WGM_GU);
            pg8::EpiSwiGLU E{WSP(bf16, WS_MID), SSQ(2)}; pg8::gemm_phase<pg8::EpiSwiGLU, pg8::StaticOrder, true, true, !H16_MASTER>(F.lds + RING_OFF, g, S, E); }
        SEAM(pb + 6); }
        _Pragma("unroll 1") for (int rp = 0; rp < NREP(9); ++rp) {
        if (EN(9) && IN(pb + 7)) { const KArgs A = kargs(); LAYER(); if (!rp) thin_resid<22>(WSP(bf16, WS_MIDM), WL(WL_D2), FF_, WSP(bf16, WS_HM), H16_MASTER ? WSP(bf16, WS_HM16) : nullptr, SSQM(3), 0.5f, THIN_ARGS); pg8::Gemm g{WSP(bf16, WS_MID), WL(WL_D2), MREAL, D_, FF_, LDM, LDM}; pg8::StaggerOrder S; S.init2(MREAL, D_, FF_, F.G, (int)blockIdx.x, STAGGER ? (int)((blockIdx.x >> 3) & 3) : 0, WGM_RES);
            pg8::EpiResid E{WSP(bf16, WS_HB), SSQ(3), rp ? 0.f : 0.5f, F.lds + XR_OFF, nullptr, H16_MASTER ? WSP(bf16, WS_H16) : nullptr}; pg8::gemm_phase<pg8::EpiResid, pg8::StaggerOrder, true, true>(F.lds + RING_OFF, g, S, E); }
        SEAM(pb + 7); }
    }
    { constexpr int Lc = 3;
        const int pb = 2 + 8 * Lc;
        _Pragma("unroll 1") for (int rp = 0; rp < NREP(2); ++rp) {
        if (EN(2) && IN(pb + 0)) { const KArgs A = kargs(); LAYER(); if (!rp) thin_gu<!H16_MASTER>(WSP(bf16, WS_HM), WL(WL_GU1), SSQM(0), WSP(bf16, WS_MIDM), THIN_ARGS); pg8::Gemm g{WSP(bf16, WS_HB), WL(WL_GU1), MREAL, 2 * FF_, D_, LDH, LDH}; pg8::StaticOrder S; S.init(MREAL, 2 * FF_, F.G, (int)blockIdx.x, WGM_GU);
#if PROBE_VAR >= 6
            if (rp) { pg8::EpiSwiGLUT<PROBE_VAR> E2{WSP(bf16, WS_MID), SSQ(0)}; pg8::gemm_phase<pg8::EpiSwiGLUT<PROBE_VAR>, pg8::StaticOrder, true, true, !H16_MASTER>(F.lds + RING_OFF, g, S, E2); } else
#elif PROBE_VAR == 1 || PROBE_VAR == 2
            if (rp) { pg8::ProbeOrder<PROBE_VAR == 2> S2; S2.init(MREAL, 2 * FF_, F.G, (int)blockIdx.x); pg8::EpiSink E2{WSP(float, WS_SSQ)}; pg8::gemm_phase<pg8::EpiSink, pg8::ProbeOrder<PROBE_VAR == 2>, true, true, !H16_MASTER>(F.lds + RING_OFF, g, S2, E2); } else
#endif
            { pg8::EpiSwiGLU E{WSP(bf16, WS_MID), SSQ(0)}; pg8::gemm_phase<pg8::EpiSwiGLU, pg8::StaticOrder, true, true, !H16_MASTER>(F.lds + RING_OFF, g, S, E); } }
        SEAM(pb + 0); }
        _Pragma("unroll 1") for (int rp = 0; rp < NREP(3); ++rp) {
        if (EN(3) && IN(pb + 1)) { const KArgs A = kargs(); LAYER(); if (!rp) thin_resid<22>(WSP(bf16, WS_MIDM), WL(WL_D1), FF_, WSP(bf16, WS_HM), H16_MASTER ? WSP(bf16, WS_HM16) : nullptr, SSQM(1), 0.5f, THIN_ARGS); pg8::Gemm g{WSP(bf16, WS_MID), WL(WL_D1), MREAL, D_, FF_, LDM, LDM}; pg8::StaggerOrder S; S.init2(MREAL, D_, FF_, F.G, (int)blockIdx.x, STAGGER ? (int)((blockIdx.x >> 3) & 3) : 0, WGM_RES);
#if PROBE_VAR >= 3 && PROBE_VAR <= 5
            if (rp) { pg8::EpiResidT<PROBE_VAR> E2{WSP(bf16, WS_HB), SSQ(1), 0.f, F.lds + XR_OFF, (bf16*)A->out, H16_MASTER ? WSP(bf16, WS_H16) : nullptr}; pg8::gemm_phase<pg8::EpiResidT<PROBE_VAR>, pg8::StaggerOrder, true, true>(F.lds + RING_OFF, g, S, E2); } else
#elif PROBE_VAR
            if (rp) { pg8::ProbeOrder<PROBE_VAR == 2> S2; S2.init(MREAL, D_, F.G, (int)blockIdx.x); pg8::EpiSink E2{WSP(float, WS_SSQ)}; pg8::gemm_phase<pg8::EpiSink, pg8::ProbeOrder<PROBE_VAR == 2>, true, true>(F.lds + RING_OFF, g, S2, E2); } else
#endif
            { pg8::EpiResid E{WSP(bf16, WS_HB), SSQ(1), rp ? 0.f : 0.5f, F.lds + XR_OFF, nullptr, H16_MASTER ? WSP(bf16, WS_H16) : nullptr}; pg8::gemm_phase<pg8::EpiResid, pg8::StaggerOrder, true, true>(F.lds + RING_OFF, g, S, E); } }
        SEAM(pb + 1); }
        _Pragma("unroll 1") for (int rp = 0; rp < NREP(4); ++rp) {
        if (EN(4) && IN(pb + 2)) { const KArgs A = kargs(); LAYER(); if (!rp) thin_proj<!H16_MASTER>(WSP(bf16, WS_HM), WL(WL_IN), SSQM(1), WSP(bf16, WS_PROJ), WSP(float, WS_ROPE), WSP(float, WS_ROPE) + NPOS * 32, THIN_ARGS); pg8::Gemm g{WSP(bf16, WS_HB), WL(WL_IN), MREAL, INW, D_, LDH, LDH}; pg8::StaticOrder S; S.init(MREAL, INW, F.G, (int)blockIdx.x, WGM_IN);
            pg8::EpiProj E{WSP(bf16, WS_PROJ), SSQ(1), WSP(float, WS_ROPE), WSP(float, WS_ROPE) + NPOS * 32}; pg8::gemm_phase<pg8::EpiProj, pg8::StaticOrder, true, true, !H16_MASTER>(F.lds + RING_OFF, g, S, E); }
        SEAM(pb + 2); }
        _Pragma("unroll 1") for (int rp = 0; rp < NREP(5); ++rp) {
        if (EN(5) && IN(pb + 3)) { const KArgs A = kargs(); LAYER(); const bf16* PROJ = WSP(bf16, WS_PROJ); bf16* CAT = WSP(bf16, WS_CAT);
            const int ln_ = LANE(); const float sa = wave_sum(A->in[8][L * 64 + ln_] * A->in[9][L * 64 + ln_]), sb = wave_sum(A->in[10][L * 64 + ln_] * A->in[11][L * 64 + ln_]);
            const float lam = expf(sa) - expf(sb) + A->lam_init[L];
            for (int v = F.vcu; v < 256; v += F.G) { const int bh = v >> 1, sx = v & 1, b = bh >> 3, h = bh & 7;
#pragma unroll 1
                for (int i = 0; i < 8; ++i) { const int m = i & 1, qs = i >> 1;
                    const int qb = sx == 0 ? (qs == 0 ? 0 : qs == 1 ? 7 : qs == 2 ? 1 : 6) : (qs == 0 ? 2 : qs == 1 ? 5 : qs == 2 ? 3 : 4);
                    const attn_body::bf16* P = (const attn_body::bf16*)PROJ + (size_t)b * VSEQ * LDP;
                    attn_body::attn_unit<8>(qb, P + (size_t)(64 + 256 * qb) * LDP + (2 * h + m) * 64, P + 1024 + (2 * h + m) * 64, P + 2048 + h * 128,
                                            (attn_body::bf16*)CAT + (size_t)(b * NSEQ + 256 * qb) * LDH + h * 128, (char*)lds + RING_OFF, m, lam, (float*)(A->ws + WS_OSCR) + (size_t)v * 32768); } }
            { bf16* CATM = WSP(bf16, WS_CATM); const int lane = LANE();
              if (gw < NHEADS && NGW > 64) cb_meta_attn(PROJ, CATM, lam, gw, lane);
              else { const int w0 = NGW > 64 ? gw - NHEADS : gw, nw = NGW > 64 ? NGW - NHEADS : NGW;
                if (NGW <= 64) for (int it = gw; it < NHEADS; it += NGW) cb_meta_attn(PROJ, CATM, lam, it, lane);
                for (int it = w0; it < NMETA + NBATCH * 128; it += nw) {
                    if (it < NMETA) cb_row((const bf16*)nullptr, PROJ, CAT, CATM, lam, MREAL + it, lane);
                    else cb_pool_item(PROJ, CAT, it - NMETA, lane); } } }
        }
        SEAM(pb + 3); }
        _Pragma("unroll 1") for (int rp = 0; rp < NREP(7); ++rp) {
        if (EN(7) && IN(pb + 5)) { const KArgs A = kargs(); LAYER(); if (!rp) thin_resid<8>(WSP(bf16, WS_CATM), WL(WL_OUT), D_, WSP(bf16, WS_HM), H16_MASTER ? WSP(bf16, WS_HM16) : nullptr, SSQM(2), 1.0f, THIN_ARGS); pg8::Gemm g{WSP(bf16, WS_CAT), WL(WL_OUT), MREAL, D_, D_, LDH, LDH}; pg8::StaggerOrder S; S.init2(MREAL, D_, D_, F.G, (int)blockIdx.x, STAGGER ? (int)((blockIdx.x >> 3) & 3) : 0, WGM_RES);
            pg8::EpiResid E{WSP(bf16, WS_HB), SSQ(2), rp ? 0.f : 1.0f, F.lds + XR_OFF, nullptr, H16_MASTER ? WSP(bf16, WS_H16) : nullptr}; pg8::gemm_phase<pg8::EpiResid, pg8::StaggerOrder, true, true>(F.lds + RING_OFF, g, S, E); }
        SEAM(pb + 5); }
        _Pragma("unroll 1") for (int rp = 0; rp < NREP(8); ++rp) {
        if (EN(8) && IN(pb + 6)) { const KArgs A = kargs(); LAYER(); if (!rp) thin_gu<!H16_MASTER>(WSP(bf16, WS_HM), WL(WL_GU2), SSQM(2), WSP(bf16, WS_MIDM), THIN_ARGS); pg8::Gemm g{WSP(bf16, WS_HB), WL(WL_GU2), MREAL, 2 * FF_, D_, LDH, LDH}; pg8::StaticOrder S; S.init(MREAL, 2 * FF_, F.G, (int)blockIdx.x, WGM_GU);
            pg8::EpiSwiGLU E{WSP(bf16, WS_MID), SSQ(2)}; pg8::gemm_phase<pg8::EpiSwiGLU, pg8::StaticOrder, true, true, !H16_MASTER>(F.lds + RING_OFF, g, S, E); }
        SEAM(pb + 6); }
        _Pragma("unroll 1") for (int rp = 0; rp < NREP(9); ++rp) {
        if (EN(9) && IN(pb + 7)) { const KArgs A = kargs(); LAYER(); if (!rp) thin_resid<22>(WSP(bf16, WS_MIDM), WL(WL_D2), FF_, WSP(bf16, WS_HM), H16_MASTER ? WSP(bf16, WS_HM16) : nullptr, SSQM(3), 0.5f, THIN_ARGS); pg8::Gemm g{WSP(bf16, WS_MID), WL(WL_D2), MREAL, D_, FF_, LDM, LDM}; pg8::StaggerOrder S; S.init2(MREAL, D_, FF_, F.G, (int)blockIdx.x, STAGGER ? (int)((blockIdx.x >> 3) & 3) : 0, WGM_RES);
            pg8::EpiResid E{WSP(bf16, WS_HB), SSQ(3), rp ? 0.f : 0.5f, F.lds + XR_OFF, nullptr, H16_MASTER ? WSP(bf16, WS_H16) : nullptr}; pg8::gemm_phase<pg8::EpiResid, pg8::StaggerOrder, true, true>(F.lds + RING_OFF, g, S, E); }
        SEAM(pb + 7); }
    }
    if (EN(10) && IN(NPHASE - 1)) { const KArgs A = kargs(); const int lane = LANE(); const bf16* HBp = H16_MASTER ? WSP(bf16, WS_H16) : WSP(bf16, WS_HB); float* outp = A->out;
        const float* ssq = (const float*)(A->ws + WS_SSQ + (size_t)12 * SSQ_SET); const float* gf = A->in[20];
        unsigned poison = 0u;
        if (hi - lo > 1) poison = __hip_atomic_load((gu32*)((gu32*)(A->ws + WS_CTL) + CW_BAR + XB_TMO), RLX_AGENT);
        for (int r = gw; r < MREAL; r += NGW) {
            float s = 0.f;
#pragma unroll
            for (int p = 0; p < 8; ++p) s += ssq[(size_t)p * MROWS + r];
            float rn = 1.0f / sqrtf(s * (1.0f / 2048.0f) + NORM_EPS); if (poison) rn = __builtin_nanf("");
            const unsigned long long* h8 = (const unsigned long long*)(HBp + (size_t)r * LDH) + lane; const f32x4* g4 = (const f32x4*)gf + lane; f32x4* o4 = (f32x4*)(outp + (size_t)r * D_) + lane;
#pragma unroll
            for (int j = 0; j < 8; ++j) { const unsigned long long w = h8[64 * j]; const unsigned w0 = (unsigned)w, w1 = (unsigned)(w >> 32);
                const f32x4 hv = (f32x4){pg8::f16_lo(w0), pg8::f16_hi(w0), pg8::f16_lo(w1), pg8::f16_hi(w1)}; o4[64 * j] = hv * rn * g4[64 * j]; }
#if PROBE
            { const unsigned long long* st = (const unsigned long long*)(A->ws + WS_STAMP); const float pa = (float)(st[PROBE_A1] - st[PROBE_A0]) * 0.01f, pbv = (float)(st[PROBE_B1] - st[PROBE_B0]) * 0.01f;
              if (r >= MREAL - 512) { for (int j = 0; j < 8; ++j) o4[64 * j] = (f32x4){pbv, pbv, pbv, pbv}; }
              if (r == 0 && lane == 0) { o4[0].x = pa; } }
#endif
        }
    }
#undef IN
#undef SEAM
#undef LAYER
#undef SSQM
#undef THIN_ARGS
#undef STAMP
#undef LANE
#undef WSP
#undef WL
#undef SSQ
}

extern "C" void kernel_launch(void* const* d_in, const int* in_sizes, int n_in, void* d_out, int out_size, void* d_ws, size_t ws_size, hipStream_t stream) {
    static int grid = 0;
    if (grid == 0) {
        if (n_in != 21 || in_sizes[0] != MREAL * D_ || out_size != MREAL * D_ || ws_size < WS_END) { fprintf(stderr, "kernel_launch: unexpected shapes (n_in %d, in0 %d, out %d, ws %zu < %zu); nothing launched\n", n_in, n_in > 0 ? in_sizes[0] : -1, out_size, ws_size, (size_t)WS_END); grid = -1; return; }
        int dev = 0, cus = 0, per_cu = 0;
        if (hipGetDevice(&dev) != hipSuccess || hipDeviceGetAttribute(&cus, hipDeviceAttributeMultiprocessorCount, dev) != hipSuccess) { grid = -1; return; }
        if (hipFuncSetAttribute((const void*)fwd_kernel, hipFuncAttributeMaxDynamicSharedMemorySize, LDS_BYTES) != hipSuccess) { fprintf(stderr, "kernel_launch: hipFuncSetAttribute failed\n"); grid = -1; return; }
        if (hipOccupancyMaxActiveBlocksPerMultiprocessor(&per_cu, (const void*)fwd_kernel, NWAVES * 64, LDS_BYTES) != hipSuccess || per_cu < 1) { fprintf(stderr, "kernel_launch: occupancy query reports %d workgroups per CU\n", per_cu); }
        (void)hipGetLastError();
        grid = cus;
    }
    if (grid < 0) return;
    if (hipMemsetAsync((char*)d_ws + WS_CTL, 0, CTL_ZERO_BYTES, stream) != hipSuccess) { fprintf(stderr, "kernel_launch: memset failed\n"); return; }
    Args a{};
    for (int i = 0; i < 21; ++i) a.in[i] = (const float*)d_in[i];
    a.out = (float*)d_out; a.ws = (unsigned char*)d_ws;
    for (int L = 0; L < 4; ++L) a.lam_init[L] = (float)(0.8 - 0.6 * exp(-0.3 * (double)L));
#if MK_ONE_LAUNCH
    a.ph_lo = 0; a.ph_hi = NPHASE;
    hipLaunchKernelGGL(fwd_kernel, dim3(grid), dim3(NWAVES * 64), LDS_BYTES, stream, a);
#else
    for (int p = 0; p < NPHASE; ++p) { a.ph_lo = p; a.ph_hi = p + 1; hipLaunchKernelGGL(fwd_kernel, dim3(grid), dim3(NWAVES * 64), LDS_BYTES, stream, a); }
#endif
    const hipError_t le = hipPeekAtLastError();
    if (le != hipSuccess) fprintf(stderr, "kernel_launch: launch failed: %s\n", hipGetErrorName(le));
}
```

```cpp
#include <hip/hip_runtime.h>
#include <hip/hip_bf16.h>
#include <cstdio>
#include <cstdint>
#include <cmath>

constexpr int D_ = 2048, NBATCH = 16, NSEQ = 2048, DEPTH = 4, NMETA = 16, FF_ = 5632, INW = 4096, NHEADS = 8;
constexpr int MREAL = NBATCH * NSEQ;
constexpr int MROWS = MREAL + 256;
constexpr int VSEQ = 2112;
constexpr int VROWS = NBATCH * VSEQ;
constexpr int NPOS = NMETA + NSEQ;
constexpr float NORM_EPS = 1e-6f, SUBLN_EPS = 1e-5f;
constexpr int LDH = D_ + 128;
constexpr int LDM = FF_ + 128;
constexpr int LDP = INW + 128;
constexpr float QSCALE = 0.125f * 1.4426950408889634f;

namespace pg8 {
#define PG8_LAS __attribute__((address_space(3)))
typedef unsigned short bf16_t;
typedef short bf16x8 __attribute__((ext_vector_type(8)));
typedef float f32x4 __attribute__((ext_vector_type(4)));
typedef unsigned u32x4 __attribute__((ext_vector_type(4)));
constexpr int BM = 256, BK = 64, HALF = 128, HTB = HALF * BK * 2  , STAGE_BYTES = 8 * HTB, NXCD = 8;

__host__ __device__ __forceinline__ int lds_byte(int r, int c) { const int st = (r >> 4) * 2 + (c >> 5), rr = r & 15, cc = c & 31, ob = rr * 64 + cc * 2; return st * 1024 + (ob ^ (((ob >> 9) & 1) << 5)); }
__host__ __device__ __forceinline__ void stage_rc(int b, int& R, int& C) { const int st = b / 1024, sb = b % 1024, swz = sb ^ (((sb >> 9) & 1) << 5); R = (st >> 1) * 16 + swz / 64; C = (st & 1) * 32 + (swz % 64) / 2; }
__host__ __device__ __forceinline__ int perm32(int rho) { const int n = rho >> 4, i = rho & 15; return 8 * (i >> 2) + 4 * n + (i & 3); }

typedef _Float16 f16x8 __attribute__((ext_vector_type(8)));
template <bool F16> __device__ __forceinline__ f32x4 mma16(bf16x8 a, bf16x8 b, f32x4 c) {
    if constexpr (F16) return __builtin_amdgcn_mfma_f32_16x16x32_f16(__builtin_bit_cast(f16x8, a), __builtin_bit_cast(f16x8, b), c, 0, 0, 0);
    else return __builtin_amdgcn_mfma_f32_16x16x32_bf16(a, b, c, 0, 0, 0); }
typedef _Float16 f16x2 __attribute__((ext_vector_type(2)));
__device__ __forceinline__ unsigned pk_f16(float lo, float hi) { f16x2 v; v.x = (_Float16)lo; v.y = (_Float16)hi; return __builtin_bit_cast(unsigned, v); }
__device__ __forceinline__ float f16_lo(unsigned w) { return (float)__builtin_bit_cast(f16x2, w).x; }
__device__ __forceinline__ float f16_hi(unsigned w) { return (float)__builtin_bit_cast(f16x2, w).y; }
struct Unit { int pm, pn, k0, nk; };
struct Gemm { const bf16_t* A; const bf16_t* Bt; int M, N, K, lda, ldb; };

struct StaticOrder {
    int nM, nN, nwg, G, c, WGM;
    __host__ __device__ void init(int M, int N, int G_, int c_, int wgm = 8) { nM = M / BM; nN = N / BM; nwg = nM * nN; G = G_; c = c_; WGM = wgm; }
    __host__ __device__ bool next(int i, Unit& u) const {
        const long L = (long)i * G + c; if (L >= nwg) return false;
        int wgid = (int)L; { const int q = nwg / NXCD, r = nwg % NXCD, xcd = wgid % NXCD, off = wgid / NXCD; wgid = (xcd < r ? xcd * (q + 1) : r * (q + 1) + (xcd - r) * q) + off; }
        const int nig = WGM * nN, gid = wgid / nig, fm = gid * WGM, gsz = (nM - fm) < WGM ? (nM - fm) : WGM;
        u.pm = fm + ((wgid % nig) % gsz); u.pn = (wgid % nig) / gsz; u.k0 = 0; u.nk = 0; return true;
    }
    __device__ __forceinline__ void a_ready(const Unit&) const {}
    __device__ __forceinline__ void done(const Unit&) const {}
};

__device__ __forceinline__ unsigned cvt_pk_bf16(float lo, float hi) { unsigned r; asm volatile("v_cvt_pk_bf16_f32 %0, %1, %2" : "=v"(r) : "v"(lo), "v"(hi)); return r; }
typedef float f32x2 __attribute__((ext_vector_type(2)));
__device__ __forceinline__ float row_rstd(const float* ssq, int row) {
    float s = 0.f;
#pragma unroll
    for (int p = 0; p < 8; ++p) s += ssq[(size_t)p * MROWS + row];
    return __builtin_amdgcn_rsqf(s * (1.0f / 2048.0f) + NORM_EPS);
}
__device__ __forceinline__ void row_scales(float (&rs)[2][4], const float* ssq, int pm, int wr, int fr, int fq) {
    const int lane = fq * 16 + fr; float r2[2];
#pragma unroll
    for (int k = 0; k < 2; ++k) r2[k] = row_rstd(ssq, pm * BM + 128 * k + 64 * wr + lane);
#pragma unroll
    for (int ai = 0; ai < 2; ++ai)
#pragma unroll
        for (int m = 0; m < 4; ++m) rs[ai][m] = __shfl(r2[ai], m * 16 + fr);
}
template <int PM = 0> struct EpiSwiGLUT {
    static constexpr bool PERM = true, AFTER_DRAIN = false;
    bf16_t* O; const float* ssq;
    __device__ __forceinline__ void operator()(const f32x4 (&acc)[2][2][4][2], const Unit& u, int wr, int wc, int fr_, int fq_) const {
        int fr = fr_, fq = fq_; asm volatile("" : "+v"(fr), "+v"(fq));
        const int row0 = u.pm * BM + wr * 64 + fr, col0 = u.pn * HALF + wc * 32 + 8 * fq;
        float rs[2][4]; if (PM == 6) { for (int a = 0; a < 2; ++a) for (int b = 0; b < 4; ++b) rs[a][b] = 1.0f; } else row_scales(rs, ssq, u.pm, wr, fr, fq);
#pragma unroll
        for (int ai = 0; ai < 2; ++ai)
#pragma unroll
            for (int m = 0; m < 4; ++m) { const float r = rs[ai][m]; f32x4 o[2];
#pragma unroll
                for (int n = 0; n < 2; ++n) { const f32x4 g = acc[ai][0][m][n] * r, up = acc[ai][1][m][n] * r, t = g * -1.4426950408889634f; f32x4 e;
#pragma unroll
                    for (int i = 0; i < 4; ++i) e[i] = PM == 8 ? t[i] : __builtin_amdgcn_rcpf(1.0f + __builtin_amdgcn_exp2f(t[i]));
                    o[n] = (g * up) * e; }
                u32x4 w; w.x = cvt_pk_bf16(o[0][0], o[0][1]); w.y = cvt_pk_bf16(o[0][2], o[0][3]); w.z = cvt_pk_bf16(o[1][0], o[1][1]); w.w = cvt_pk_bf16(o[1][2], o[1][3]);
                if (PM == 0) *(u32x4*)(O + (size_t)(row0 + ai * HALF + m * 16) * LDM + col0) = w; else if (w.x == 0x12345678u) O[0] = 1; }
    }
};
typedef EpiSwiGLUT<0> EpiSwiGLU;
template <int PM = 0> struct EpiResidT {
    static constexpr bool PERM = true, AFTER_DRAIN = false;
    bf16_t* HB; float* ssq_out; float scale; PG8_LAS unsigned char* xr; bf16_t* dummy; bf16_t* H16; int nocopy;
    __device__ __forceinline__ void operator()(const f32x4 (&acc)[2][2][4][2], const Unit& u, int wr, int wc, int fr_, int fq_) const {
        int fr = fr_, fq = fq_; asm volatile("" : "+v"(fr), "+v"(fq));
        const int row0 = u.pm * BM + wr * 64 + fr, col0 = u.pn * BM + wc * 32 + 8 * fq;
        PG8_LAS float* XS = (PG8_LAS float*)xr + (wr * 4 + wc) * 128;
#pragma unroll
        for (int ai = 0; ai < 2; ++ai) {
            u32x4 old[4][2];
#pragma unroll
            for (int m = 0; m < 4; ++m)
#pragma unroll
                for (int bj = 0; bj < 2; ++bj) { if (PM == 4 || PM == 5) old[m][bj] = (u32x4){0u, 0u, 0u, 0u}; else old[m][bj] = *(const u32x4*)((H16 ? H16 : HB) + (size_t)(row0 + ai * HALF + m * 16) * LDH + col0 + bj * HALF); }
#pragma unroll
            for (int m = 0; m < 4; ++m) { bf16_t* bp = (PM == 4 ? dummy : HB) + (size_t)(row0 + ai * HALF + m * 16) * LDH + col0; f32x4 sq = (f32x4){0.f, 0.f, 0.f, 0.f};
#pragma unroll
                for (int bj = 0; bj < 2; ++bj) { const u32x4 o = old[m][bj];
                    f32x4 h0 = (f32x4){f16_lo(o.x), f16_hi(o.x), f16_lo(o.y), f16_hi(o.y)}, h1 = (f32x4){f16_lo(o.z), f16_hi(o.z), f16_lo(o.w), f16_hi(o.w)};
                    h0 = h0 + acc[ai][bj][m][0] * scale; h1 = h1 + acc[ai][bj][m][1] * scale;
                    u32x4 w; w.x = pk_f16(h0[0], h0[1]); w.y = pk_f16(h0[2], h0[3]); w.z = pk_f16(h1[0], h1[1]); w.w = pk_f16(h1[2], h1[3]);
                    if (PM == 0 || PM == 4) { if (H16) { *(u32x4*)(H16 + (size_t)(row0 + ai * HALF + m * 16) * LDH + col0 + bj * HALF) = w; if (!nocopy) { u32x4 wb; wb.x = cvt_pk_bf16(h0[0], h0[1]); wb.y = cvt_pk_bf16(h0[2], h0[3]); wb.z = cvt_pk_bf16(h1[0], h1[1]); wb.w = cvt_pk_bf16(h1[2], h1[3]); *(u32x4*)(bp + bj * HALF) = wb; } } else *(u32x4*)(bp + bj * HALF) = w; }
                    sq = sq + h0 * h0 + h1 * h1; }
                float s = (sq[0] + sq[1]) + (sq[2] + sq[3]);
                s += __shfl_xor(s, 16); s += __shfl_xor(s, 32);
                if (fq == 0) XS[ai * 64 + m * 16 + fr] = s; }
            asm volatile("" ::: "memory"); }
        asm volatile("s_waitcnt lgkmcnt(0)" ::: "memory");
        PG8_LAS unsigned* cnt = (PG8_LAS unsigned*)(xr + 4096) + wr;
        unsigned old_c = 0u; const int lane = fq * 16 + fr;
        if (lane == 0) old_c = __hip_atomic_fetch_add(cnt, 1u, __ATOMIC_RELAXED, __HIP_MEMORY_SCOPE_WORKGROUP);
        old_c = (unsigned)__builtin_amdgcn_readfirstlane((int)old_c);
        asm volatile("" ::: "memory");
        if ((old_c & 3u) == 3u) {
            const PG8_LAS float* X0 = (const PG8_LAS float*)xr + (wr * 4) * 128;
#pragma unroll
            for (int k = 0; k < 2; ++k) { const int q = lane + 64 * k; const float t = ((X0[q] + X0[128 + q]) + X0[256 + q]) + X0[384 + q];
                if (PM == 0) ssq_out[(size_t)u.pn * MROWS + u.pm * BM + 128 * k + 64 * wr + lane] = t; else if (t == 1.2345e30f) ssq_out[0] = t; }
            asm volatile("s_waitcnt lgkmcnt(0)" ::: "memory");
        }
    }
};
typedef EpiResidT<0> EpiResid;
struct EpiProj {
    static constexpr bool PERM = true, AFTER_DRAIN = false;
    bf16_t* P; const float* ssq; const float* rcos; const float* rsin;
    __device__ __forceinline__ void operator()(const f32x4 (&acc)[2][2][4][2], const Unit& u, int wr, int wc, int fr_, int fq_) const {
        int fr = fr_, fq = fq_; asm volatile("" : "+v"(fr), "+v"(fq));
        const int rt0 = wr * 64 + fr, pn = u.pn;
        float rs[2][4]; row_scales(rs, ssq, u.pm, wr, fr, fq);
#pragma unroll
        for (int ai = 0; ai < 2; ++ai)
#pragma unroll
            for (int m = 0; m < 4; ++m) { const int rt = rt0 + ai * HALF + m * 16; float r = rs[ai][m];
                int vrow, pos;
                if (u.pm < MREAL / BM) { const int b = u.pm >> 3, t = (u.pm & 7) * BM + rt; vrow = b * VSEQ + 64 + t; pos = NMETA + t; }
                else { const int b = rt >> 4, j = rt & 15; vrow = b * VSEQ + 48 + j; pos = j; }
                bf16_t* op = P + (size_t)vrow * LDP + pn * BM;
                if (pn < 8) {
                    if (pn < 4) r *= QSCALE;
                    const int f0 = 16 * (wc & 1) + 4 * fq;
                    const f32x4 c = *(const f32x4*)(rcos + pos * 32 + f0), s = *(const f32x4*)(rsin + pos * 32 + f0);
#pragma unroll
                    for (int bj = 0; bj < 2; ++bj) { const f32x4 xl = acc[ai][bj][m][0] * r, xh = acc[ai][bj][m][1] * r;
                        const f32x4 ol = xl * c - xh * s, oh = xh * c + xl * s;
                        typedef unsigned u32x2v __attribute__((ext_vector_type(2)));
                        u32x2v wl, wh; wl.x = cvt_pk_bf16(ol[0], ol[1]); wl.y = cvt_pk_bf16(ol[2], ol[3]); wh.x = cvt_pk_bf16(oh[0], oh[1]); wh.y = cvt_pk_bf16(oh[2], oh[3]);
                        bf16_t* hp = op + 64 * (2 * bj + (wc >> 1)) + f0;
                        *(u32x2v*)hp = wl; *(u32x2v*)(hp + 32) = wh; }
                } else {
#pragma unroll
                    for (int bj = 0; bj < 2; ++bj) { const f32x4 v0 = acc[ai][bj][m][0] * r, v1 = acc[ai][bj][m][1] * r;
                        u32x4 w; w.x = cvt_pk_bf16(v0[0], v0[1]); w.y = cvt_pk_bf16(v0[2], v0[3]); w.z = cvt_pk_bf16(v1[0], v1[1]); w.w = cvt_pk_bf16(v1[2], v1[3]);
                        *(u32x4*)(op + bj * HALF + wc * 32 + 8 * fq) = w; }
                }
                asm volatile("" ::: "memory");
            }
    }
};

struct StaggerOrder : StaticOrder {
    int j, ntf, nu;
    __device__ void init2(int M, int N, int K, int G_, int c_, int j_, int wgm = 8) { init(M, N, G_, c_, wgm); j = j_; ntf = K / BK; nu = (nwg - c_ + G_ - 1) / G_; if (nu < 2) j = 0; }
    __device__ bool next(int i, Unit& u) const {
        if (j == 0) return StaticOrder::next(i, u);
        if (i > nu) return false;
        const int n1 = (ntf * j / 4) & ~1;
        if (i == 0) { StaticOrder::next(0, u); u.k0 = n1; u.nk = ntf - n1; return true; }
        if (i == nu) { StaticOrder::next(0, u); u.k0 = 0; u.nk = n1; return true; }
        return StaticOrder::next(i, u);
    }
};
template <class Epi, class Sched, bool ALIGN_EPI = false, bool SP2 = false, bool F16 = false  >
__device__ __forceinline__ void gemm_phase(PG8_LAS unsigned char* lds, const Gemm g, const Sched& S, const Epi& E) {
    int tid_ = threadIdx.x; asm volatile("" : "+v"(tid_));
    const int tid = tid_, wid = __builtin_amdgcn_readfirstlane(tid >> 6), lane = tid & 63, wr = wid >> 2, wc = wid & 3, fr = lane & 15, fq = lane >> 4;
    const int K = g.K, nt = K / BK;
    unsigned voffA[2], voffB[2];
#pragma unroll
    for (int i = 0; i < 2; ++i) { int R, C; stage_rc(tid * 16 + i * 8192, R, C); const int Rb = Epi::PERM ? ((R & ~31) + perm32(R & 31)) : R;
        voffA[i] = (unsigned)(R * g.lda + C) * 2u; voffB[i] = (unsigned)(Rb * g.ldb + C) * 2u; }
    const size_t kstep = (size_t)(BK * 2);
    const size_t hstepA = (size_t)HALF * g.lda * 2, hstepB = (size_t)HALF * g.ldb * 2;
    const size_t tstepA = 2 * hstepA, tstepB = 2 * hstepB;
    const unsigned ldsw = (unsigned)wid * 1024u;
    const int aoff = lds_byte(wr * 64 + fr, fq * 8), boff = lds_byte(wc * 32 + fr, fq * 8);
#define PG8_SA(b, h) (((b) * 2 + (h)) * HTB)
#define PG8_SB(b, h) ((4 + (b) * 2 + (h)) * HTB)
#define PG8_STAGE(bufoff, gbase, voff) do { _Pragma("unroll") for (int _i = 0; _i < 2; ++_i) \
        __builtin_amdgcn_global_load_lds((const unsigned*)((const char*)(gbase) + (voff)[_i]), (PG8_LAS unsigned*)(lds + (bufoff) + ldsw + _i * 8192), 16, 0, 0); } while (0)
#define PG8_LDA(dst, b, h) do { _Pragma("unroll") for (int m = 0; m < 4; ++m) _Pragma("unroll") for (int k = 0; k < 2; ++k) dst[m][k] = *(const PG8_LAS bf16x8*)(lds + PG8_SA(b, h) + aoff + m * 2048 + k * 1024); } while (0)
#define PG8_LDB(dst, b, h) do { _Pragma("unroll") for (int n = 0; n < 2; ++n) _Pragma("unroll") for (int k = 0; k < 2; ++k) dst[n][k] = *(const PG8_LAS bf16x8*)(lds + PG8_SB(b, h) + boff + n * 2048 + k * 1024); } while (0)
#define PG8_MMA(ai, bj, At, Bt) do { __builtin_amdgcn_s_setprio(1); _Pragma("unroll") for (int m = 0; m < 4; ++m) _Pragma("unroll") for (int n = 0; n < 2; ++n) _Pragma("unroll") for (int k = 0; k < 2; ++k) \
        acc[ai][bj][m][n] = mma16<F16>(Bt[n][k], At[m][k], acc[ai][bj][m][n]); __builtin_amdgcn_s_setprio(0); } while (0)
#define PG8_WAIT_V(n) asm volatile("s_waitcnt vmcnt(" #n ")" ::: "memory")
#define PG8_WAIT_L(n) asm volatile("s_waitcnt lgkmcnt(" #n ")" ::: "memory")
#define PG8_BAR __builtin_amdgcn_s_barrier()
#define PG8_SCHED __builtin_amdgcn_sched_barrier(0)
    Unit cur, nxt; int ui = 0;
    if (!S.next(0, cur)) return;
    f32x4 acc[2][2][4][2];
#pragma unroll
    for (int a = 0; a < 2; ++a)
#pragma unroll
        for (int b = 0; b < 2; ++b)
#pragma unroll
            for (int m = 0; m < 4; ++m)
#pragma unroll
                for (int n = 0; n < 2; ++n) acc[a][b][m][n] = (f32x4){0.f, 0.f, 0.f, 0.f};
    bf16x8 At[4][2], B0[2][2], B1[2][2];
    const char* cA = (const char*)g.A + (size_t)cur.pm * tstepA + (size_t)cur.k0 * kstep; const char* cB = (const char*)g.Bt + (size_t)cur.pn * tstepB + (size_t)cur.k0 * kstep;
    S.a_ready(cur);
    if constexpr (SP2) {
        PG8_STAGE(PG8_SB(0, 0), cB, voffB); PG8_STAGE(PG8_SB(0, 1), cB + hstepB, voffB); PG8_STAGE(PG8_SA(0, 0), cA, voffA); PG8_STAGE(PG8_SA(0, 1), cA + hstepA, voffA);
        if (wr == 1) PG8_BAR;
        PG8_WAIT_V(2); PG8_BAR;
        PG8_STAGE(PG8_SB(1, 0), cB + kstep, voffB); PG8_STAGE(PG8_SA(1, 0), cA + kstep, voffA); PG8_STAGE(PG8_SB(1, 1), cB + hstepB + kstep, voffB);
        PG8_WAIT_V(6); PG8_BAR;
    } else {
        PG8_STAGE(PG8_SB(0, 0), cB, voffB); PG8_STAGE(PG8_SA(0, 0), cA, voffA); PG8_STAGE(PG8_SB(0, 1), cB + hstepB, voffB); PG8_STAGE(PG8_SA(0, 1), cA + hstepA, voffA);
        if (wr == 1) PG8_BAR;
        PG8_WAIT_V(4); PG8_BAR;
        PG8_STAGE(PG8_SB(1, 0), cB + kstep, voffB); PG8_STAGE(PG8_SA(1, 0), cA + kstep, voffA); PG8_STAGE(PG8_SB(1, 1), cB + hstepB + kstep, voffB);
        PG8_WAIT_V(6); PG8_BAR;
    }
    for (;;) {
        const bool has_next = S.next(ui + 1, nxt);
        const char* nA = has_next ? (const char*)g.A + (size_t)nxt.pm * tstepA + (size_t)nxt.k0 * kstep : cA; const char* nB = has_next ? (const char*)g.Bt + (size_t)nxt.pn * tstepB + (size_t)nxt.k0 * kstep : cB;
        const int unt = cur.nk ? cur.nk : nt;
        for (int t = 0; t < unt; t += 2) {
            const bool last = (t == unt - 2);
            const char* a1 = cA + (size_t)(t + 1) * kstep;
            const char* a2 = last ? nA : cA + (size_t)(t + 2) * kstep; const char* b2 = last ? nB : cB + (size_t)(t + 2) * kstep;
            const char* a3 = a2 + kstep; const char* b3 = b2 + kstep;
            if (last && has_next) S.a_ready(nxt);
            if constexpr (SP2) {
            PG8_LDB(B0, 0, 0); PG8_LDB(B1, 0, 1); PG8_SCHED; PG8_LDA(At, 0, 0); PG8_STAGE(PG8_SA(1, 1), a1 + hstepA, voffA);
            PG8_WAIT_V(8); PG8_WAIT_L(0); PG8_BAR; PG8_MMA(0, 0, At, B0); PG8_MMA(0, 1, At, B1); PG8_BAR; PG8_SCHED;
            PG8_LDA(At, 0, 1); PG8_STAGE(PG8_SB(0, 0), b2, voffB); PG8_STAGE(PG8_SB(0, 1), b2 + hstepB, voffB); PG8_STAGE(PG8_SA(0, 0), a2, voffA);
            PG8_WAIT_V(8); PG8_WAIT_L(0); PG8_BAR; PG8_MMA(1, 0, At, B0); PG8_MMA(1, 1, At, B1); PG8_BAR; PG8_SCHED;
            PG8_LDB(B0, 1, 0); PG8_LDB(B1, 1, 1); PG8_SCHED; PG8_LDA(At, 1, 0); PG8_STAGE(PG8_SA(0, 1), a2 + hstepA, voffA);
            PG8_WAIT_V(8); PG8_WAIT_L(0); PG8_BAR; PG8_MMA(0, 0, At, B0); PG8_MMA(0, 1, At, B1); PG8_BAR; PG8_SCHED;
            PG8_LDA(At, 1, 1); PG8_STAGE(PG8_SB(1, 0), b3, voffB); PG8_STAGE(PG8_SB(1, 1), b3 + hstepB, voffB); PG8_STAGE(PG8_SA(1, 0), a3, voffA);
            PG8_WAIT_V(8); PG8_WAIT_L(0); PG8_BAR; PG8_MMA(1, 0, At, B0); PG8_MMA(1, 1, At, B1); PG8_BAR; PG8_SCHED;
            } else {
            PG8_LDB(B0, 0, 0); PG8_SCHED; PG8_LDA(At, 0, 0); PG8_STAGE(PG8_SA(1, 1), a1 + hstepA, voffA);
            PG8_WAIT_L(8); PG8_BAR; PG8_WAIT_L(0); PG8_MMA(0, 0, At, B0); PG8_BAR; PG8_SCHED;
            PG8_LDB(B1, 0, 1); PG8_STAGE(PG8_SB(0, 0), b2, voffB);
            PG8_BAR; PG8_WAIT_L(0); PG8_MMA(0, 1, At, B1); PG8_BAR;
            PG8_LDA(At, 0, 1); PG8_STAGE(PG8_SA(0, 0), a2, voffA);
            PG8_BAR; PG8_WAIT_L(0); PG8_MMA(1, 0, At, B0); PG8_BAR; PG8_SCHED;
            PG8_STAGE(PG8_SB(0, 1), b2 + hstepB, voffB);
            PG8_WAIT_V(6); PG8_BAR; PG8_MMA(1, 1, At, B1); PG8_BAR;
            PG8_LDB(B0, 1, 0); PG8_SCHED; PG8_LDA(At, 1, 0); PG8_STAGE(PG8_SA(0, 1), a2 + hstepA, voffA);
            PG8_WAIT_L(8); PG8_BAR; PG8_WAIT_L(0); PG8_MMA(0, 0, At, B0); PG8_BAR; PG8_SCHED;
            PG8_LDB(B1, 1, 1); PG8_STAGE(PG8_SB(1, 0), b3, voffB);
            PG8_BAR; PG8_WAIT_L(0); PG8_MMA(0, 1, At, B1); PG8_BAR;
            PG8_LDA(At, 1, 1); PG8_STAGE(PG8_SA(1, 0), a3, voffA);
            PG8_BAR; PG8_WAIT_L(0); PG8_MMA(1, 0, At, B0); PG8_BAR; PG8_SCHED;
            PG8_STAGE(PG8_SB(1, 1), b3 + hstepB, voffB);
            PG8_WAIT_V(6); PG8_BAR; PG8_MMA(1, 1, At, B1); PG8_BAR;
            }
        }
        if constexpr (ALIGN_EPI) { if (wr == 0) PG8_BAR; }
        if constexpr (!Epi::AFTER_DRAIN) { E(acc, cur, wr, wc, fr, fq); S.done(cur); }
        if (!has_next) break;
#pragma unroll
        for (int a = 0; a < 2; ++a)
#pragma unroll
            for (int b = 0; b < 2; ++b)
#pragma unroll
                for (int m = 0; m < 4; ++m)
#pragma unroll
                    for (int n = 0; n < 2; ++n) acc[a][b][m][n] = (f32x4){0.f, 0.f, 0.f, 0.f};
        cur = nxt; cA = nA; cB = nB; ++ui;
        if constexpr (ALIGN_EPI) { if (wr == 1) PG8_BAR; }
    }
    PG8_WAIT_V(0);
    if constexpr (!ALIGN_EPI) { if (wr == 0) PG8_BAR; }
    PG8_BAR;
    if constexpr (Epi::AFTER_DRAIN) { E.fused(acc, cur, wr, wc, fr, fq, lds, wid, lane); S.done(cur); }
#undef PG8_SA
#undef PG8_SB
#undef PG8_STAGE
#undef PG8_LDA
#undef PG8_LDB
#undef PG8_MMA
#undef PG8_WAIT_V
#undef PG8_WAIT_L
#undef PG8_BAR
#undef PG8_SCHED
}
}

namespace attn_body {
using bf16=__hip_bfloat16;
using bf16x8=__attribute__((ext_vector_type(8)))short;
using s16x4=__attribute__((ext_vector_type(4)))short;
using f32x16=__attribute__((ext_vector_type(16)))float;
using u32x4=__attribute__((ext_vector_type(4)))unsigned;
using f32x4=__attribute__((ext_vector_type(4)))float;
constexpr int D=64,QP=LDP,OP=LDH;
constexpr int NW=8,QBLK=32,QB=QBLK*NW,KVBLK=64;
constexpr int ATTN_UNIT_ROWS=QB;
__device__ __forceinline__ int crow(int r,int hi){return (r&3)+8*(r>>2)+4*hi;}
#define SBAR() __builtin_amdgcn_sched_barrier(0)
__device__ __forceinline__ void cmask(f32x16&p0,f32x16&p1,int jb,int qrel,int hi){
  const float NEG=-INFINITY; int kb=64*jb+4*hi;
  #pragma unroll
  for(int r=0;r<16;++r){int kv=kb+(r&3)+8*(r>>2); if(kv>qrel)p0[r]=NEG; if(kv+32>qrel)p1[r]=NEG;}
}

constexpr int NSLOT=3, SLOTB=8192;
constexpr int VSLOTB=2*SLOTB;
constexpr int LDS_K=0, LDS_V=NSLOT*SLOTB, LDS_WS=LDS_V+NSLOT*VSLOTB, LDS_OST=LDS_WS+NW*64*4, LDS_BYTES=LDS_OST+NW*4096;
constexpr float C2=0.125f*1.4426950408889634f;
__device__ __forceinline__ void glds16(const void*gsrc,unsigned lds_dst){unsigned keep;
  asm volatile("s_mov_b32 %0, m0\n\ts_mov_b32 m0, %2\n\ts_nop 0\n\tglobal_load_lds_dwordx4 %1, off\n\ts_mov_b32 m0, %0":"=&s"(keep):"v"(gsrc),"s"(lds_dst):"memory");}
__device__ __forceinline__ float max3f(float a,float b,float c){float r;asm("v_max3_f32 %0, %1, %2, %3":"=v"(r):"v"(a),"v"(b),"v"(c));return r;}
__device__ __forceinline__ float max2f(float a,float b){float r;asm("v_max_f32_e32 %0, %1, %2":"=v"(r):"v"(a),"v"(b));return r;}
__device__ __forceinline__ float fadd_s(float a,float b){float r;asm("v_add_f32_e32 %0, %1, %2":"=v"(r):"v"(a),"v"(b));return r;}
__device__ __forceinline__ float fsub_s(float a,float b){float r;asm("v_sub_f32_e32 %0, %1, %2":"=v"(r):"v"(a),"v"(b));return r;}
typedef float f32x2_t __attribute__((ext_vector_type(2))); typedef __bf16 bf16x2_t __attribute__((ext_vector_type(2)));
__device__ __forceinline__ unsigned cvtpk_s(float lo,float hi){f32x2_t v={lo,hi};bf16x2_t b=__builtin_convertvector(v,bf16x2_t);return __builtin_bit_cast(unsigned,b);}
#define WAIT_BAR(N) asm volatile("s_waitcnt vmcnt(" #N ") lgkmcnt(0)\n\ts_barrier":::"memory")

__device__ __forceinline__ void qkt(f32x16&p0,f32x16&p1,const char*Kslot,const bf16x8*qr,const f32x16&negm,int r32,int hi){
  const char*kb=Kslot+hi*1024+r32*16;
  #pragma unroll
  for(int d0=0;d0<4;++d0){
    const bf16x8 b0=*reinterpret_cast<const bf16x8*>(kb+d0*2048);
    const bf16x8 b1=*reinterpret_cast<const bf16x8*>(kb+d0*2048+512);
    if(d0==0){p0=__builtin_amdgcn_mfma_f32_32x32x16_bf16(b0,qr[0],negm,0,0,0);p1=__builtin_amdgcn_mfma_f32_32x32x16_bf16(b1,qr[0],negm,0,0,0);}
    else{p0=__builtin_amdgcn_mfma_f32_32x32x16_bf16(b0,qr[d0],p0,0,0,0);p1=__builtin_amdgcn_mfma_f32_32x32x16_bf16(b1,qr[d0],p1,0,0,0);}}
}
typedef __attribute__((address_space(3))) const char* lds_cptr;
typedef short v4i16_t __attribute__((ext_vector_type(4)));
__device__ __forceinline__ void kload8(bf16x8*kf,lds_cptr kp){
  kf[0]=*(const __attribute__((address_space(3))) bf16x8*)(kp);      kf[1]=*(const __attribute__((address_space(3))) bf16x8*)(kp+512);
  kf[2]=*(const __attribute__((address_space(3))) bf16x8*)(kp+2048); kf[3]=*(const __attribute__((address_space(3))) bf16x8*)(kp+2560);
  kf[4]=*(const __attribute__((address_space(3))) bf16x8*)(kp+4096); kf[5]=*(const __attribute__((address_space(3))) bf16x8*)(kp+4608);
  kf[6]=*(const __attribute__((address_space(3))) bf16x8*)(kp+6144); kf[7]=*(const __attribute__((address_space(3))) bf16x8*)(kp+6656);
}
__device__ __forceinline__ void kload2(bf16x8*kf,lds_cptr kp,int j){ kf[2*j]=*(const __attribute__((address_space(3))) bf16x8*)(kp+j*2048); kf[2*j+1]=*(const __attribute__((address_space(3))) bf16x8*)(kp+j*2048+512); }
__device__ __forceinline__ s16x4 vtr(lds_cptr p){ return __builtin_bit_cast(s16x4,__builtin_amdgcn_ds_read_tr16_b64_v4i16((__attribute__((address_space(3))) v4i16_t*)p)); }
__device__ __forceinline__ float rowmax(const f32x16&p0,const f32x16&p1){
  float a=max3f(p0[0],p0[1],p1[0]),b=max3f(p0[2],p0[3],p1[1]);a=max3f(a,p1[2],p1[3]);
  #pragma unroll
  for(int r=4;r<16;r+=4){a=max3f(a,p0[r],p0[r+1]);b=max3f(b,p0[r+2],p0[r+3]);a=max3f(a,p1[r],p1[r+1]);b=max3f(b,p1[r+2],p1[r+3]);}
  const float m=max2f(a,b);
  auto rr=__builtin_amdgcn_permlane32_swap(__float_as_uint(m),__float_as_uint(m),false,false);
  return max2f(__uint_as_float(rr[0]),__uint_as_float(rr[1]));
}
__device__ __forceinline__ void pv(f32x16*o,int vb,bf16x8 pa0,bf16x8 pa1,bf16x8 pa2,bf16x8 pa3){
  #pragma unroll
  for(int d0=0;d0<4;++d0){s16x4 lo[4],hi[4];
    #pragma unroll
    for(int ks=0;ks<4;++ks){
      asm volatile("ds_read_b64_tr_b16 %0,%1 offset:%c2":"=&v"(lo[ks]):"v"(vb),"i"(d0*4096+ks*1024):"memory");
      asm volatile("ds_read_b64_tr_b16 %0,%1 offset:%c2":"=&v"(hi[ks]):"v"(vb),"i"(d0*4096+ks*1024+512):"memory");}
    asm volatile("s_waitcnt lgkmcnt(0)":::"memory");SBAR();
    #define PK(k) (bf16x8){lo[k][0],lo[k][1],lo[k][2],lo[k][3],hi[k][0],hi[k][1],hi[k][2],hi[k][3]}
    o[d0]=__builtin_amdgcn_mfma_f32_32x32x16_bf16(pa0,PK(0),o[d0],0,0,0);
    o[d0]=__builtin_amdgcn_mfma_f32_32x32x16_bf16(pa1,PK(1),o[d0],0,0,0);
    o[d0]=__builtin_amdgcn_mfma_f32_32x32x16_bf16(pa2,PK(2),o[d0],0,0,0);
    o[d0]=__builtin_amdgcn_mfma_f32_32x32x16_bf16(pa3,PK(3),o[d0],0,0,0);
    #undef PK
  }
}

#ifndef ATTN_STORE16
#define ATTN_STORE16(p,v) (*(u32x4*)(p)=(v))
#endif
template<int THRL> __device__ __forceinline__ void attn_unit(int qb,const bf16*Q0,const bf16*__restrict__ Kh,const bf16*__restrict__ Vh,bf16*O0,char*shm,int mode,float lam,float*oscr){
  int tid_=threadIdx.x; asm volatile("":"+v"(tid_));
  const int tid=tid_,lane=tid&63,r32=lane&31,hi=lane>>5; const int wid=__builtin_amdgcn_readfirstlane(tid>>6);
  const bf16*Qw=Q0+(long)(wid*QBLK)*QP;
  const unsigned lds0=(unsigned)(uintptr_t)shm;
  float*wsf=(float*)(shm+LDS_WS)+wid*64;
  const bf16*ksrc=Kh+(long)lane*QP+wid*8;
  const bf16*vsrc=Vh+(long)(16*(wid&3)+(lane>>2))*QP+(wid>>2)*32+(lane&3)*8;
  const unsigned kdst=lds0+LDS_K+wid*1024, vdst=lds0+LDS_V+wid*1024;
  #define DMA_K(t,slot) glds16(ksrc+(long)(t)*KVBLK*QP,(unsigned)__builtin_amdgcn_readfirstlane(kdst+(slot)))
  #define DMA_V(t,slot) do{ glds16(vsrc+(long)(t)*KVBLK*QP,(unsigned)__builtin_amdgcn_readfirstlane(vdst+2*(slot))); glds16(vsrc+64+(long)(t)*KVBLK*QP,(unsigned)__builtin_amdgcn_readfirstlane(vdst+2*(slot)+8192)); }while(0)
  const int vb0=(int)(lds0+LDS_V)+((lane>>4)&1)*32+(lane&3)*8+(4*hi+((lane&15)>>2))*64;
  const char*Kbase=shm+LDS_K; bf16x8 kf[8];
  const lds_cptr shm3=(lds_cptr)shm; const lds_cptr kp0=shm3+LDS_K+hi*1024+r32*16; const lds_cptr vp0=shm3+LDS_V+((lane>>4)&1)*32+(lane&3)*8+(4*hi+((lane&15)>>2))*64;
  const int NT=4*qb+5;
  DMA_K(0,0);DMA_V(0,0);DMA_K(1,SLOTB);
  bf16x8 qr[4];
  #pragma unroll
  for(int d0=0;d0<4;++d0)qr[d0]=*reinterpret_cast<const bf16x8*>(&Qw[(long)r32*QP+d0*16+hi*8]);
  float mhat=0.f,l_reg=0.f;float z0_=0.f; asm volatile("":"+v"(z0_));
  f32x16 o[4]; _Pragma("unroll") for(int q_=0;q_<4;++q_) _Pragma("unroll") for(int r=0;r<16;++r)o[q_][r]=z0_; f32x16 negm; _Pragma("unroll") for(int r=0;r<16;++r)negm[r]=z0_; asm volatile("":"+v"(negm));
  const int qrel=wid*QBLK+r32;
  #define CMASK(P0,P1,t) do{int jb_=(t)-(NT-4); if(jb_>=0)cmask(P0,P1,jb_,qrel,hi);}while(0)
  bool resc=false;
  #define START(P0,P1) do{ const float rm=rowmax(P0,P1); resc=false; \
    { const float dl=rm; mhat=fadd_s(mhat,dl); \
      _Pragma("unroll") for(int r=0;r<16;++r){P0[r]=fsub_s(P0[r],dl);P1[r]=fsub_s(P1[r],dl);} \
      _Pragma("unroll") for(int r=0;r<16;++r)negm[r]=-mhat; asm volatile("":"+v"(negm)); } \
    _Pragma("unroll") for(int r=0;r<16;++r)P0[r]=__builtin_amdgcn_exp2f(P0[r]); }while(0)
  #define RESC() do{ if(resc){ asm volatile("s_waitcnt lgkmcnt(0)":::"memory"); \
      _Pragma("unroll") for(int d_=0;d_<4;++d_) _Pragma("unroll") for(int r=0;r<16;++r)o[d_][r]*=wsf[crow(r,hi)]; } }while(0)
  f32x16 pA0,pA1,pB0,pB1;
  int sl_prev=0,sl_cur=0,sl_next=SLOTB;
  #define ROT() do{sl_prev=sl_cur;sl_cur=sl_next;sl_next=(sl_next==(NSLOT-1)*SLOTB)?0:sl_next+SLOTB;}while(0)
  DMA_K(2,2*SLOTB);
  WAIT_BAR(4);
  qkt(pA0,pA1,Kbase,qr,negm,r32,hi);asm volatile("s_nop 15\n\ts_nop 7":"+v"(pA0),"+v"(pA1));
  { const float NEGI=-INFINITY;
    _Pragma("unroll") for(int r=0;r<16;++r)pA0[r]=NEGI;
    _Pragma("unroll") for(int r=0;r<8;++r)pA1[r]=NEGI; }
  START(pA0,pA1);
  _Pragma("unroll") for(int r=0;r<16;++r)pA1[r]=__builtin_amdgcn_exp2f(pA1[r]);
  WAIT_BAR(0);
  DMA_K(3,0);DMA_V(1,SLOTB);
  ROT();
  kload8(kf,kp0+sl_cur);
  WAIT_BAR(3);
  s16x4 vlo[4],vhi[4]; u32x4 pw0,pw1,pw2,pw3;
  #define PKW(P,B) cvtpk_s(P[B],P[B+1])
  #define PAF(k) __builtin_bit_cast(bf16x8,pw##k)
  #define VFR(i) (bf16x8){vlo[i][0],vlo[i][1],vlo[i][2],vlo[i][3],vhi[i][0],vhi[i][1],vhi[i][2],vhi[i][3]}
  #define PIN(x) asm volatile("":"+v"(x))
  #define MX3(a,b,c) __builtin_fmaxf(__builtin_fmaxf((a),(b)),(c))
  #define GAPA(MF,A0,A1,A2,A3,W0,W1,PW) do{ MF; sacc+=A0; sacc+=A1; sacc+=A2; sacc+=A3; PIN(sacc); W0; W1; PIN(PW); SBAR(); }while(0)
  #define EX(v) __builtin_amdgcn_exp2f(v)
  #define GAPB(MF,X,B) do{ MF; X[B]=EX(X[B]); X[B+1]=EX(X[B+1]); PIN(X); SBAR(); }while(0)
  #define VRD(s,i) do{ vlo[s]=vtr(vp_+(((i)>>2)*4096+((i)&3)*1024)); vhi[s]=vtr(vp_+(((i)>>2)*4096+((i)&3)*1024+512)); }while(0)
  #define KRD(G,j) do{ if(G){ kload2(kf,kp0+sl_next,j); SBAR(); } }while(0)
  #define STEP(C0,C1,P0,P1,t,GK,GV,GL) do{ SBAR(); \
    const lds_cptr vp_=vp0+2*sl_prev; \
    VRD(0,0); SBAR(); float sacc=(P0[0]+P0[1]); \
    GAPA(C0=__builtin_amdgcn_mfma_f32_32x32x16_bf16(kf[0],qr[0],negm,0,0,0), P0[2],P0[3],P0[4],P0[5],     pw0[0]=PKW(P0,0), pw0[1]=PKW(P0,2), pw0); \
    VRD(1,4); SBAR(); GAPA(C1=__builtin_amdgcn_mfma_f32_32x32x16_bf16(kf[1],qr[0],negm,0,0,0), P0[6],P0[7],P0[8],P0[9],     pw0[2]=PKW(P0,4), pw0[3]=PKW(P0,6), pw0); \
    VRD(2,8); SBAR(); GAPA(C0=__builtin_amdgcn_mfma_f32_32x32x16_bf16(kf[2],qr[1],C0,0,0,0),   P0[10],P0[11],P0[12],P0[13], pw1[0]=PKW(P0,8), pw1[1]=PKW(P0,10), pw1); \
    VRD(3,12); SBAR(); GAPA(C1=__builtin_amdgcn_mfma_f32_32x32x16_bf16(kf[3],qr[1],C1,0,0,0),   P0[14],P0[15],P1[0],P1[1],   pw1[2]=PKW(P0,12),pw1[3]=PKW(P0,14), pw1); \
    GAPA(C0=__builtin_amdgcn_mfma_f32_32x32x16_bf16(kf[4],qr[2],C0,0,0,0),   P1[2],P1[3],P1[4],P1[5],     pw2[0]=PKW(P1,0), pw2[1]=PKW(P1,2), pw2); \
    GAPA(C1=__builtin_amdgcn_mfma_f32_32x32x16_bf16(kf[5],qr[2],C1,0,0,0),   P1[6],P1[7],P1[8],P1[9],     pw2[2]=PKW(P1,4), pw2[3]=PKW(P1,6), pw2); \
    GAPA(C0=__builtin_amdgcn_mfma_f32_32x32x16_bf16(kf[6],qr[3],C0,0,0,0),   P1[10],P1[11],P1[12],P1[13], pw3[0]=PKW(P1,8), pw3[1]=PKW(P1,10), pw3); \
    GAPA(C1=__builtin_amdgcn_mfma_f32_32x32x16_bf16(kf[7],qr[3],C1,0,0,0),   P1[14],P1[15],0.f,0.f,       pw3[2]=PKW(P1,12),pw3[3]=PKW(P1,14), pw3); \
    l_reg+=sacc; \
    if(GK){DMA_K((t)+3,sl_cur);} if(GV){DMA_V((t)+1,sl_next);} \
    CMASK(C0,C1,t); \
    { float a=MX3(C0[0],C0[1],C1[0]),b=MX3(C0[2],C0[3],C1[1]); a=MX3(a,C1[2],C1[3]); \
      _Pragma("unroll") for(int r=4;r<16;r+=4){a=MX3(a,C0[r],C0[r+1]);b=MX3(b,C0[r+2],C0[r+3]);a=MX3(a,C1[r],C1[r+1]);b=MX3(b,C1[r+2],C1[r+3]);} \
      float rm=__builtin_fmaxf(a,b); { auto rr=__builtin_amdgcn_permlane32_swap(__float_as_uint(rm),__float_as_uint(rm),false,false); rm=__builtin_fmaxf(__uint_as_float(rr[0]),__uint_as_float(rr[1])); } \
      resc=false; \
      if(__builtin_expect(__any(rm>(float)THRL),0)){ const float dl=__builtin_fmaxf(rm,0.f); mhat+=dl; \
        _Pragma("unroll") for(int r=0;r<16;++r){C0[r]-=dl;C1[r]-=dl;} \
        _Pragma("unroll") for(int r=0;r<16;++r)negm[r]=-mhat; asm volatile("":"+v"(negm)); \
        const float f=__builtin_amdgcn_exp2f(-dl); l_reg*=f; if(hi==0)wsf[r32]=f; resc=true; } } \
    SBAR(); \
    GAPB(o[0]=__builtin_amdgcn_mfma_f32_32x32x16_bf16(PAF(0),VFR(0),o[0],0,0,0), C0,0);  VRD(0,1);  SBAR(); \
    GAPB(o[1]=__builtin_amdgcn_mfma_f32_32x32x16_bf16(PAF(0),VFR(1),o[1],0,0,0), C0,2);  VRD(1,5);  SBAR(); \
    GAPB(o[2]=__builtin_amdgcn_mfma_f32_32x32x16_bf16(PAF(0),VFR(2),o[2],0,0,0), C0,4);  VRD(2,9);  SBAR(); \
    GAPB(o[3]=__builtin_amdgcn_mfma_f32_32x32x16_bf16(PAF(0),VFR(3),o[3],0,0,0), C0,6);  VRD(3,13); SBAR(); \
    GAPB(o[0]=__builtin_amdgcn_mfma_f32_32x32x16_bf16(PAF(1),VFR(0),o[0],0,0,0), C0,8);  VRD(0,2);  SBAR(); \
    KRD(GL,0); GAPB(o[1]=__builtin_amdgcn_mfma_f32_32x32x16_bf16(PAF(1),VFR(1),o[1],0,0,0), C0,10); VRD(1,6);  SBAR(); \
    GAPB(o[2]=__builtin_amdgcn_mfma_f32_32x32x16_bf16(PAF(1),VFR(2),o[2],0,0,0), C0,12); VRD(2,10); SBAR(); \
    KRD(GL,1); GAPB(o[3]=__builtin_amdgcn_mfma_f32_32x32x16_bf16(PAF(1),VFR(3),o[3],0,0,0), C0,14); VRD(3,14); SBAR(); \
    GAPB(o[0]=__builtin_amdgcn_mfma_f32_32x32x16_bf16(PAF(2),VFR(0),o[0],0,0,0), C1,0);  VRD(0,3);  SBAR(); \
    KRD(GL,2); GAPB(o[1]=__builtin_amdgcn_mfma_f32_32x32x16_bf16(PAF(2),VFR(1),o[1],0,0,0), C1,2);  VRD(1,7);  SBAR(); \
    GAPB(o[2]=__builtin_amdgcn_mfma_f32_32x32x16_bf16(PAF(2),VFR(2),o[2],0,0,0), C1,4);  VRD(2,11); SBAR(); \
    KRD(GL,3); GAPB(o[3]=__builtin_amdgcn_mfma_f32_32x32x16_bf16(PAF(2),VFR(3),o[3],0,0,0), C1,6);  VRD(3,15); SBAR(); \
    GAPB(o[0]=__builtin_amdgcn_mfma_f32_32x32x16_bf16(PAF(3),VFR(0),o[0],0,0,0), C1,8); \
    GAPB(o[1]=__builtin_amdgcn_mfma_f32_32x32x16_bf16(PAF(3),VFR(1),o[1],0,0,0), C1,10); \
    GAPB(o[2]=__builtin_amdgcn_mfma_f32_32x32x16_bf16(PAF(3),VFR(2),o[2],0,0,0), C1,12); \
    GAPB(o[3]=__builtin_amdgcn_mfma_f32_32x32x16_bf16(PAF(3),VFR(3),o[3],0,0,0), C1,14); \
    }while(0)
  int t=1;
  #undef CMASK
  #define CMASK(P0,P1,t) do{}while(0)
  for(;t+5<NT;t+=2){
    STEP(pB0,pB1,pA0,pA1,t,true,true,true);     WAIT_BAR(3); RESC(); ROT();
    STEP(pA0,pA1,pB0,pB1,t+1,true,true,true);   WAIT_BAR(3); RESC(); ROT();
  }
  #undef CMASK
  #define CMASK(P0,P1,t) do{int jb_=(t)-(NT-4); if(jb_>=0)cmask(P0,P1,jb_,qrel,hi);}while(0)
  #define ENDW(tt) do{ if((tt)+3<NT){WAIT_BAR(3);} else if((tt)+2<NT){WAIT_BAR(2);} else {WAIT_BAR(0);} }while(0)
  for(;t+3<NT;t+=2){
    STEP(pB0,pB1,pA0,pA1,t,(t+3<NT),(t+1<NT),(t+1<NT));       ENDW(t);   RESC(); ROT();
    STEP(pA0,pA1,pB0,pB1,t+1,(t+4<NT),(t+2<NT),(t+2<NT));     ENDW(t+1); RESC(); ROT();
  }
  STEP(pB0,pB1,pA0,pA1,t,false,true,true);        WAIT_BAR(0); RESC(); ROT();
  STEP(pA0,pA1,pB0,pB1,NT-1,false,false,false); RESC();
  { float sacc=pA0[0]+pA0[1]; _Pragma("unroll") for(int r=2;r<16;++r)sacc+=pA0[r]; _Pragma("unroll") for(int r=0;r<16;++r)sacc+=pA1[r]; l_reg+=sacc;
    pw0=(u32x4){PKW(pA0,0),PKW(pA0,2),PKW(pA0,4),PKW(pA0,6)};pw1=(u32x4){PKW(pA0,8),PKW(pA0,10),PKW(pA0,12),PKW(pA0,14)};pw2=(u32x4){PKW(pA1,0),PKW(pA1,2),PKW(pA1,4),PKW(pA1,6)};pw3=(u32x4){PKW(pA1,8),PKW(pA1,10),PKW(pA1,12),PKW(pA1,14)};
    SBAR(); pv(o,vb0+2*sl_cur,PAF(0),PAF(1),PAF(2),PAF(3)); }
  #undef PKW
  #undef PAF
  #undef VFR
  #undef PIN
  #undef MX3
  #undef GAPA
  #undef GAPB
  #undef EX
  #undef VRD
  #undef KRD
  #undef STEP
  #undef ENDW
  {auto rr=__builtin_amdgcn_permlane32_swap(__float_as_uint(l_reg),__float_as_uint(l_reg),false,false);l_reg=__uint_as_float(rr[0])+__uint_as_float(rr[1]);}
  if(hi==0)wsf[32+r32]=l_reg;asm volatile("s_waitcnt lgkmcnt(0)":::"memory");
  float rli[16];
  #pragma unroll
  for(int r=0;r<16;++r)rli[r]=__builtin_amdgcn_rcpf(wsf[32+crow(r,hi)]);
  #pragma unroll
  for(int q_=0;q_<4;++q_) _Pragma("unroll") for(int r=0;r<16;++r)o[q_][r]*=rli[r];
  f32x4*sc4=(f32x4*)oscr+(size_t)wid*16*64+lane;
  if(mode==0){
    #pragma unroll
    for(int q_=0;q_<4;++q_) _Pragma("unroll") for(int j=0;j<4;++j) sc4[(q_*4+j)*64]=(f32x4){o[q_][4*j],o[q_][4*j+1],o[q_][4*j+2],o[q_][4*j+3]};
  } else {
    float ss[16];
    #pragma unroll
    for(int r=0;r<16;++r)ss[r]=0.f;
    #pragma unroll
    for(int q_=0;q_<4;++q_) _Pragma("unroll") for(int j=0;j<4;++j){ const f32x4 a=sc4[(q_*4+j)*64];
      _Pragma("unroll") for(int e=0;e<4;++e){ const float d=a[e]-lam*o[q_][4*j+e]; o[q_][4*j+e]=d; ss[4*j+e]+=d*d; } }
    #pragma unroll
    for(int r=0;r<16;++r){ float v=ss[r]; v+=__shfl_xor(v,1); v+=__shfl_xor(v,2); v+=__shfl_xor(v,4); v+=__shfl_xor(v,8); v+=__shfl_xor(v,16); ss[r]=__builtin_amdgcn_rsqf(v*(1.0f/128.0f)+1e-5f); }
    bf16*Ow=O0+(long)(wid*QBLK)*OP;
    bf16*stg=(bf16*)(shm+LDS_OST)+wid*2048;
    #pragma unroll
    for(int dh=0;dh<2;++dh){
      #pragma unroll
      for(int r=0;r<16;++r){const int orow=crow(r,hi);
        #pragma unroll
        for(int d0=0;d0<2;++d0)stg[orow*64+d0*32+r32]=__float2bfloat16(o[2*dh+d0][r]*ss[r]);}
      asm volatile("s_waitcnt lgkmcnt(0)":::"memory");
      #pragma unroll
      for(int i=0;i<4;++i){const int row=i*8+(lane>>3),ch=lane&7; const u32x4 v=*(const u32x4*)(stg+row*64+ch*8); ATTN_STORE16(Ow+(long)row*OP+dh*64+ch*8,v);}
      asm volatile("s_waitcnt lgkmcnt(0)":::"memory"); } }
  asm volatile("s_waitcnt lgkmcnt(0)\n\ts_barrier":::"memory");
  #undef DMA_K
  #undef DMA_V
  #undef CMASK
  #undef START
  #undef RESC
  #undef ROT
}
constexpr int ATTN_LDS_BYTES=LDS_BYTES;
#undef SBAR
#undef WAIT_BAR
}

#define GAS __attribute__((address_space(1)))
#define LAS __attribute__((address_space(3)))
typedef unsigned short bf16;
typedef unsigned v4u __attribute__((ext_vector_type(4)));
typedef float f32x4 __attribute__((ext_vector_type(4)));
typedef short bf16x8 __attribute__((ext_vector_type(8)));
typedef GAS unsigned gu32;
typedef GAS unsigned long long gu64;
#define RLX_AGENT __ATOMIC_RELAXED, __HIP_MEMORY_SCOPE_AGENT
#define LDS_WAIT() asm volatile("s_waitcnt lgkmcnt(0)" ::: "memory")
#define VM_WAIT() asm volatile("s_waitcnt vmcnt(0)" ::: "memory")
__device__ __forceinline__ unsigned long long rt() { return __builtin_amdgcn_s_memrealtime(); }
__device__ __forceinline__ unsigned f2bf(float f) { unsigned u = __builtin_bit_cast(unsigned, f); return (u + 0x7fffu + ((u >> 16) & 1u)) >> 16; }
__device__ __forceinline__ unsigned pk2(float lo, float hi) { return f2bf(lo) | (f2bf(hi) << 16); }

#define XB_TMO      128
#define XB_XCNT(j)  (256  + 64 * (j))
#define XB_XSUB(j)  (1280 + 64 * (j))
#define XB_XGEN(j)  (2304 + 64 * (j))
#define XB_TOP      3328
#define XB_TOPGEN   3392
#define XCD_BAR_WORDS 3456
#define XB_SPIN_CAP (1u << 18)

__device__ __forceinline__ unsigned xb_ld(unsigned* p)              { return __hip_atomic_load(p, __ATOMIC_RELAXED, __HIP_MEMORY_SCOPE_AGENT); }
__device__ __forceinline__ unsigned xb_add(unsigned* p, unsigned v) { return __hip_atomic_fetch_add(p, v, __ATOMIC_RELAXED, __HIP_MEMORY_SCOPE_AGENT); }
__device__ __forceinline__ unsigned xb_xcc_id() { return (unsigned)__builtin_amdgcn_s_getreg((3 << 11) | 20) & 0xFu; }
#define XB_SPIN(cond, bar) do { unsigned _sp = 0; while (cond) { __builtin_amdgcn_s_sleep(1); \
    if ((++_sp & 255u) == 0u) { if (xb_ld(&(bar)[XB_TMO])) break; if (_sp > XB_SPIN_CAP) { atomicAdd(&(bar)[XB_TMO], 1u); break; } } } } while (0)

struct XcdBarrier {
    unsigned* bar; unsigned x;
    volatile LAS unsigned* st;
};

__device__ __forceinline__ XcdBarrier xcd_barrier_post(unsigned* bar, volatile LAS unsigned* st) {
    XcdBarrier b; b.bar = bar; b.x = xb_xcc_id(); b.st = st;
    if (threadIdx.x == 0) (void)xb_add(&bar[XB_XCNT(b.x)], 1u);
    return b;
}
__device__ __forceinline__ void xcd_barrier_complete(unsigned* bar, unsigned x, unsigned& nloc, unsigned& nx) {
    const unsigned G = gridDim.x * gridDim.y * gridDim.z;
    unsigned sum, cnt, mine, sp = 0u;
    for (;;) {
        sum = 0u; cnt = 0u; mine = 0u;
#pragma unroll
        for (unsigned j = 0; j < 16; ++j) { const unsigned c = xb_ld(&bar[XB_XCNT(j)]); sum += c; cnt += (c > 0u) ? 1u : 0u; mine = (j == x) ? c : mine; }
        if (sum == G) break;
        __builtin_amdgcn_s_sleep(1);
        if ((++sp & 255u) == 0u) { if (xb_ld(&bar[XB_TMO])) break; if (sp > XB_SPIN_CAP) { atomicAdd(&bar[XB_TMO], 1u); break; } }
    }
    nloc = mine > 0u ? mine : 1u; nx = cnt > 0u ? cnt : 1u;
}

__device__ __forceinline__ void xcd_barrier(const XcdBarrier& b) {
    asm volatile("s_waitcnt vmcnt(0)" ::: "memory");
    __syncthreads();
    if (threadIdx.x == 0) {
        unsigned* bar = b.bar;
        __builtin_amdgcn_s_waitcnt(0);
        unsigned nloc = b.st[0], nx = b.st[1];
        if (nloc == 0u) { xcd_barrier_complete(bar, b.x, nloc, nx); b.st[0] = nloc; b.st[1] = nx; }
        const unsigned old = xb_add(&bar[XB_XSUB(b.x)], 1u);
        const unsigned gen = old / nloc;
        if (old + 1u == (gen + 1u) * nloc) {
            __builtin_amdgcn_fence(__ATOMIC_RELEASE, "agent");
            asm volatile("s_waitcnt vmcnt(0)" ::: "memory");
            const unsigned og = xb_add(&bar[XB_TOP], 1u);
            const unsigned tg = og / nx;
            if (og + 1u == (tg + 1u) * nx) xb_add(&bar[XB_TOPGEN], 1u);
            else XB_SPIN(xb_ld(&bar[XB_TOPGEN]) == tg, bar);
            __builtin_amdgcn_fence(__ATOMIC_ACQUIRE, "agent");
            xb_add(&bar[XB_XGEN(b.x)], 1u);
            asm volatile("s_waitcnt vmcnt(0)" ::: "memory");
        } else {
            XB_SPIN(xb_ld(&bar[XB_XGEN(b.x)]) == gen, bar);
            __builtin_amdgcn_fence(__ATOMIC_ACQUIRE, "agent");
            asm volatile("s_waitcnt vmcnt(0)" ::: "memory");
        }
    }
    __syncthreads();
}

constexpr size_t MiB = 1u << 20;
constexpr size_t WS_CTL = 0, CTL_ZERO_BYTES = 1 * MiB;
constexpr size_t WS_ROPE = 1 * MiB;
constexpr size_t WS_SSQ = 2 * MiB;
constexpr size_t SSQ_SET = (size_t)8 * MROWS * 4;
constexpr size_t WS_HM = 16 * MiB;
constexpr size_t WS_MIDM = 17 * MiB;
constexpr size_t WS_CATM = 18 * MiB;
constexpr size_t WS_SSQM = 19 * MiB;
constexpr size_t SSQM_SET = (size_t)128 * 16 * 4;
constexpr size_t WS_HM16 = 20 * MiB;
constexpr size_t WS_H16 = 32 * MiB;
constexpr size_t WS_OSCR = 168 * MiB;
constexpr size_t WS_HB = 200 * MiB;
constexpr size_t WS_BIG = 336 * MiB;
constexpr size_t WS_PROJ = WS_BIG, WS_CAT = WS_BIG + 273 * MiB, WS_MID = WS_BIG;
constexpr size_t WS_WTS = 745 * MiB;
constexpr size_t WL_GU1 = 0, WL_D1 = 47 * MiB, WL_IN = 70 * MiB, WL_OUT = 87 * MiB, WL_GU2 = 96 * MiB, WL_D2 = 143 * MiB, WL_BYTES = 166 * MiB;
constexpr size_t WS_END = WS_WTS + 4 * WL_BYTES;
static_assert(SSQ_SET * 13 <= 14 * MiB && (size_t)MREAL * LDH * 2 <= 136 * MiB && (size_t)MREAL * LDM * 2 <= 409 * MiB && (size_t)VROWS * LDP * 2 <= 273 * MiB && WS_CAT + (size_t)MREAL * LDH * 2 <= WS_WTS && WS_H16 + 136 * MiB <= WS_OSCR && WS_OSCR + 32 * MiB <= WS_HB && WS_HB + 136 * MiB <= WS_BIG, "d_ws map");
static_assert((size_t)2 * FF_ * LDH * 2 <= 47 * MiB && (size_t)D_ * LDM * 2 <= 23 * MiB && (size_t)INW * LDH * 2 <= 17 * MiB && (size_t)D_ * LDH * 2 <= 9 * MiB, "weight map");
constexpr int CW_BAR = 4096;
constexpr int NPHASE = 2 + 8 * DEPTH + 1;

constexpr int RING_OFF = 0, RING_BYTES = 131072;
constexpr int LDSCTL_OFF = RING_BYTES;
constexpr int XR_OFF = LDSCTL_OFF, MISC_OFF = LDSCTL_OFF + 4352;
constexpr int LDS_BYTES = 147456;
static_assert(MISC_OFF + 128 <= LDS_BYTES, "LDS map");
constexpr int NWAVES = 8;

struct Args { const float* in[21]; float* out; unsigned char* ws; int ph_lo, ph_hi; float lam_init[4]; };
struct Frame {
    LAS unsigned char* lds; volatile LAS unsigned* MISC; gu32* ctl;
    int wave, vcu, G;
};
__device__ __forceinline__ float wave_sum(float v) {
#pragma unroll
    for (int o = 1; o < 64; o <<= 1) v += __shfl_xor(v, o);
    return v;
}
__device__ __forceinline__ float bf_lo(unsigned w) { return __builtin_bit_cast(float, w << 16); }
__device__ __forceinline__ float bf_hi(unsigned w) { return __builtin_bit_cast(float, w & 0xffff0000u); }

#ifndef H16_MASTER
#define H16_MASTER 1
#endif
__device__ __forceinline__ void fold_item(const float* w_in, const float* w_pool, const float* pool_scale, const float* kgain, bf16* WTin, int item, int lane) {

    const int k0 = (item & 255) * 8, g = (item >> 8) & 3, L = item >> 10;
    const float* A = w_in + ((size_t)L * D_ + k0) * INW + 3072 + 256 * g;
    const float* Bm = w_pool + ((size_t)(L * 4 + g) * 256) * 256 + 4 * lane;
    f32x4 acc[8];
#pragma unroll
    for (int r = 0; r < 8; ++r) acc[r] = (f32x4){0.f, 0.f, 0.f, 0.f};
#pragma unroll 1
    for (int cc = 0; cc < 256; cc += 16) {
        f32x4 b[16], a[8][4];
#pragma unroll
        for (int q = 0; q < 16; ++q) b[q] = *(const f32x4*)(Bm + (size_t)(cc + q) * 256);
#pragma unroll
        for (int r = 0; r < 8; ++r)
#pragma unroll
            for (int q4 = 0; q4 < 4; ++q4) a[r][q4] = *(const f32x4*)(A + (size_t)r * INW + cc + 4 * q4);
#pragma unroll
        for (int r = 0; r < 8; ++r)
#pragma unroll
            for (int q4 = 0; q4 < 4; ++q4) acc[r] = acc[r] + b[4 * q4] * a[r][q4][0] + b[4 * q4 + 1] * a[r][q4][1] + b[4 * q4 + 2] * a[r][q4][2] + b[4 * q4 + 3] * a[r][q4][3];
    }
    const f32x4 sc = *(const f32x4*)(pool_scale + (size_t)L * 1024 + 256 * g + 4 * lane);
    float gk[8];
#pragma unroll
    for (int r = 0; r < 8; ++r) gk[r] = kgain[(size_t)L * D_ + k0 + r];
#pragma unroll
    for (int jj = 0; jj < 4; ++jj) { float o[8];
#pragma unroll
        for (int r = 0; r < 8; ++r) o[r] = acc[r][jj] * sc[jj] * gk[r];
        v4u w;
        if (!H16_MASTER) { w.x = pg8::pk_f16(o[0], o[1]); w.y = pg8::pk_f16(o[2], o[3]); w.z = pg8::pk_f16(o[4], o[5]); w.w = pg8::pk_f16(o[6], o[7]); }
        else { w.x = pk2(o[0], o[1]); w.y = pk2(o[2], o[3]); w.z = pk2(o[4], o[5]); w.w = pk2(o[6], o[7]); }
        *(v4u*)(WTin + ((size_t)(3072 + 256 * g + 4 * lane + jj)) * LDH + k0) = w; }
}
__device__ __forceinline__ void hinit_row(const float* x, const float* meta, bf16* HB, bf16* H16, float* ssq0, int row, int lane) {
    const float* src = row < MREAL ? x + (size_t)row * D_ : meta + (size_t)((row - MREAL) & 15) * D_;
    const f32x4* s4 = (const f32x4*)src + lane;
    unsigned long long* b8 = (unsigned long long*)(HB + (size_t)row * LDH) + lane;
    float ss = 0.f;
#pragma unroll
    for (int j = 0; j < 8; ++j) { const f32x4 v = s4[64 * j]; ss += (v.x * v.x + v.y * v.y) + (v.z * v.z + v.w * v.w);
        const unsigned long long wf = (unsigned long long)pg8::pk_f16(v.x, v.y) | ((unsigned long long)pg8::pk_f16(v.z, v.w) << 32);
        if (H16) { ((unsigned long long*)(H16 + (size_t)row * LDH) + lane)[64 * j] = wf; b8[64 * j] = (unsigned long long)pk2(v.x, v.y) | ((unsigned long long)pk2(v.z, v.w) << 32); } else b8[64 * j] = wf; }
    ss = wave_sum(ss);
    if (lane < 8) ssq0[(size_t)lane * MROWS + row] = lane == 0 ? ss : 0.f;
}
__device__ __forceinline__ void hinit_meta(const float* meta, bf16* HM, bf16* HM16, float* ssqm0, int j, int lane) {
    const f32x4* s4 = (const f32x4*)(meta + (size_t)j * D_) + lane; unsigned long long* b8 = (unsigned long long*)(HM + (size_t)j * D_) + lane; float ss = 0.f;
#pragma unroll
    for (int q = 0; q < 8; ++q) { const f32x4 v = s4[64 * q]; ss += (v.x * v.x + v.y * v.y) + (v.z * v.z + v.w * v.w);
        const unsigned long long wf = (unsigned long long)pg8::pk_f16(v.x, v.y) | ((unsigned long long)pg8::pk_f16(v.z, v.w) << 32);
        if (HM16) { ((unsigned long long*)(HM16 + (size_t)j * D_) + lane)[64 * q] = wf; b8[64 * q] = (unsigned long long)pk2(v.x, v.y) | ((unsigned long long)pk2(v.z, v.w) << 32); } else b8[64 * q] = wf; }
    ss = wave_sum(ss);
    for (int q = lane; q < 128; q += 64) ssqm0[q * 16 + j] = q == 0 ? ss : 0.f;
}
template <bool F16, int NACC, int BS = 8  > __device__ __forceinline__ void thin_mma(f32x4 (&acc)[NACC], const bf16* A16, const bf16* Bt, int K, const int (&c0)[NACC], int wave, int lane, LAS float* red) {

    const int fr = lane & 15, fq = lane >> 4, kw = K >> 3;
#pragma unroll
    for (int a = 0; a < NACC; ++a) acc[a] = (f32x4){0.f, 0.f, 0.f, 0.f};
    const bf16* ap = A16 + (size_t)fr * K + wave * kw + 8 * fq;
    const bf16* bp[NACC];
#pragma unroll
    for (int a = 0; a < NACC; ++a) bp[a] = Bt + (size_t)(c0[a] + fr) * (K + 128) + wave * kw + 8 * fq;
    for (int kb = 0; kb < kw; kb += 32 * BS) {
        const int ns = (kw - kb) >= 32 * BS ? BS : ((kw - kb) >> 5);
        bf16x8 av[BS], bv[NACC][BS];
#pragma unroll
        for (int s = 0; s < BS; ++s) { const int k = kb + 32 * (s < ns ? s : 0); av[s] = *(const bf16x8*)(ap + k);
#pragma unroll
            for (int a = 0; a < NACC; ++a) bv[a][s] = *(const bf16x8*)(bp[a] + k); }
#pragma unroll
        for (int s = 0; s < BS; ++s) if (s < ns) {
#pragma unroll
            for (int a = 0; a < NACC; ++a) acc[a] = pg8::mma16<F16>(bv[a][s], av[s], acc[a]); } }
#pragma unroll
    for (int a = 0; a < NACC; ++a) *(LAS f32x4*)(red + ((wave * NACC + a) * 64 + lane) * 4) = acc[a];
    __syncthreads();
    if (wave == 0) {
#pragma unroll
        for (int w = 1; w < 8; ++w)
#pragma unroll
            for (int a = 0; a < NACC; ++a) acc[a] = acc[a] + *(const LAS f32x4*)(red + ((w * NACC + a) * 64 + lane) * 4);
    }
    __syncthreads();
}
__device__ __forceinline__ float meta_rstd(const float* ssqm, int lane) {
    const int fr = lane & 15, fq = lane >> 4; float s = 0.f;
#pragma unroll 8
    for (int q = 0; q < 32; ++q) s += ssqm[(fq * 32 + q) * 16 + fr];
    s += __shfl_xor(s, 16); s += __shfl_xor(s, 32);
    return __builtin_amdgcn_rsqf(s * (1.0f / 2048.0f) + NORM_EPS);
}
typedef unsigned u32x2t __attribute__((ext_vector_type(2)));
template <bool F16> __device__ __forceinline__ void thin_gu(const bf16* HM, const bf16* Bt, const float* ssqm, bf16* MIDM, int vcu, int G, int wave, int lane, LAS float* red) {
    for (int t = vcu; t < FF_ / 32; t += G) { const int cb = 256 * (t >> 2) + 32 * (t & 3); const int c0[4] = {cb, cb + 16, cb + 128, cb + 144}; f32x4 acc[4];
        float r = 0.f; if (wave == 0) r = meta_rstd(ssqm, lane);
        thin_mma<F16, 4>(acc, HM, Bt, D_, c0, wave, lane, red);
        if (wave == 0) { const int fr = lane & 15, fq = lane >> 4;
#pragma unroll
            for (int hf = 0; hf < 2; ++hf) { const f32x4 g = acc[hf] * r, up = acc[2 + hf] * r; f32x4 o;
#pragma unroll
                for (int i = 0; i < 4; ++i) o[i] = g[i] * up[i] * __builtin_amdgcn_rcpf(1.0f + __builtin_amdgcn_exp2f(g[i] * -1.4426950408889634f));
                u32x2t w; w.x = pk2(o[0], o[1]); w.y = pk2(o[2], o[3]); *(u32x2t*)(MIDM + (size_t)fr * FF_ + 32 * t + 16 * hf + 4 * fq) = w; } } }
}
template <int BS> __device__ __forceinline__ void thin_resid(const bf16* A16, const bf16* Bt, int K, bf16* HM, bf16* HM16, float* ssqm_out, float scale, int vcu, int G, int wave, int lane, LAS float* red) {
    for (int t = vcu; t < D_ / 16; t += G) { const int c0[1] = {16 * t}; f32x4 acc[1];
        u32x2t* hp = (u32x2t*)((HM16 ? HM16 : HM) + (size_t)(lane & 15) * D_ + 16 * t + 4 * (lane >> 4)); u32x2t o = (u32x2t){0u, 0u}; if (wave == 0) o = *hp;
        thin_mma<false, 1, BS>(acc, A16, Bt, K, c0, wave, lane, red);
        if (wave == 0) { const int fr = lane & 15, fq = lane >> 4;
            f32x4 h = (f32x4){pg8::f16_lo(o.x), pg8::f16_hi(o.x), pg8::f16_lo(o.y), pg8::f16_hi(o.y)}; h = h + acc[0] * scale;
            u32x2t w; w.x = pg8::pk_f16(h[0], h[1]); w.y = pg8::pk_f16(h[2], h[3]); *hp = w;
            if (HM16) { u32x2t wb; wb.x = pk2(h[0], h[1]); wb.y = pk2(h[2], h[3]); *(u32x2t*)(HM + (size_t)fr * D_ + 16 * t + 4 * fq) = wb; }
            float s = (h[0] * h[0] + h[1] * h[1]) + (h[2] * h[2] + h[3] * h[3]); s += __shfl_xor(s, 16); s += __shfl_xor(s, 32);
            if (fq == 0) ssqm_out[t * 16 + fr] = s; } }
}
template <bool F16> __device__ __forceinline__ void thin_proj(const bf16* HM, const bf16* Bt, const float* ssqm, bf16* P, const float* rcos, const float* rsin, int vcu, int G, int wave, int lane, LAS float* red) {
    for (int t = vcu; t < INW / 16; t += G) { const int c0[1] = {16 * t}; f32x4 acc[1];
        float r = 0.f; if (wave == 0) r = meta_rstd(ssqm, lane);
        thin_mma<F16, 1>(acc, HM, Bt, D_, c0, wave, lane, red);
        if (wave == 0) { const int fr = lane & 15, fq = lane >> 4; int col; f32x4 o;
            if (t < 128) { if (t < 64) r *= QSCALE; const int pb = (16 * t) & 63, n = fq & 1, dlo = 16 * (pb >> 5) + 4 * ((((pb >> 3) & 3) + (fq >> 1)) & 3);
                const f32x4 own = acc[0] * r; f32x4 oth;
#pragma unroll
                for (int i = 0; i < 4; ++i) oth[i] = __shfl_xor(own[i], 16);
                const f32x4 c = *(const f32x4*)(rcos + fr * 32 + dlo), s = *(const f32x4*)(rsin + fr * 32 + dlo);
                o = n ? (own * c + oth * s) : (own * c - oth * s); col = ((16 * t) & ~63) + 32 * n + dlo; }
            else { o = acc[0] * r; col = 16 * t + 4 * fq; }
            u32x2t w; w.x = pk2(o[0], o[1]); w.y = pk2(o[2], o[3]);
#pragma unroll 4
            for (int b = 0; b < NBATCH; ++b) *(u32x2t*)(P + (size_t)(b * VSEQ + 48 + fr) * LDP + col) = w; } }
}
__device__ __forceinline__ void conv_item(int kind, const float* W0, const float* W1, const float* kgain, float aux, bf16* WT, int K, int nsrc, int nnb, int item, int lane) {
    const int kb = item / nnb, nb = item - kb * nnb, c = nb * 64 + lane, k0 = kb * 256;
    const float* src; int pitch = nsrc;
    if (kind == 1) { const int pn = c >> 8, bj = (c >> 7) & 1, j = 128 * pn + (c & 127); src = (bj ? W1 : W0) + j; }
    else if (kind == 2) {
        if (c < 2048) { const int p = c & 63; const int d = 32 * ((p >> 2) & 1) + 16 * (p >> 5) + 4 * ((p >> 3) & 3) + (p & 3); src = W0 + (c & ~63) + d; }
        else src = W0 + c;
    } else src = W0 + c;
    src += (size_t)k0 * pitch;
    bf16* dst = WT + (size_t)c * (K + 128) + k0;
    float v[32];
#pragma unroll
    for (int e = 0; e < 32; ++e) v[e] = src[(size_t)e * pitch];
#pragma unroll 1
    for (int kc = 0; kc < 8; ++kc) {
        float nv[32];
        const int kn = kc < 7 ? kc + 1 : kc;
#pragma unroll
        for (int e = 0; e < 32; ++e) nv[e] = src[(size_t)(kn * 32 + e) * pitch];
#pragma unroll
        for (int e = 0; e < 32; ++e) { const int k = k0 + kc * 32 + e; float gk = 1.f;
            if (kind == 1 || kind == 2) gk = kgain[k]; else if (kind == 3) gk = k < 1024 ? kgain[k & 127] * aux : 1.f;
            v[e] *= gk; }
#pragma unroll
        for (int q = 0; q < 4; ++q) { v4u o;
            if (!H16_MASTER && (kind == 1 || kind == 2)) { o.x = pg8::pk_f16(v[8 * q], v[8 * q + 1]); o.y = pg8::pk_f16(v[8 * q + 2], v[8 * q + 3]); o.z = pg8::pk_f16(v[8 * q + 4], v[8 * q + 5]); o.w = pg8::pk_f16(v[8 * q + 6], v[8 * q + 7]); }
            else { o.x = pk2(v[8 * q], v[8 * q + 1]); o.y = pk2(v[8 * q + 2], v[8 * q + 3]); o.z = pk2(v[8 * q + 4], v[8 * q + 5]); o.w = pk2(v[8 * q + 6], v[8 * q + 7]); }
            *(v4u*)(dst + kc * 32 + 8 * q) = o; }
#pragma unroll
        for (int e = 0; e < 32; ++e) v[e] = nv[e];
    }
}
__device__ __forceinline__ const float* conv_src(int kind, const float* W0, const float* W1, int c) {
    if (kind == 1) { const int pn = c >> 8, bj = (c >> 7) & 1, j = 128 * pn + (c & 127); return (bj ? W1 : W0) + j; }
    if (kind == 2 && c < 2048) { const int pp = c & 63; const int d = 32 * ((pp >> 2) & 1) + 16 * (pp >> 5) + 4 * ((pp >> 3) & 3); return W0 + (c & ~63) + d; }
    return W0 + c;
}
__device__ __forceinline__ void conv_run(int kind, const float* W0, const float* W1, const float* kgain, float aux, bf16* WT, int K, int nsrc, int nnb, int nitems, int gw, int NGW, int lane_in, LAS float* scr) {
    int lane = lane_in; asm volatile("" : "+v"(lane));
    const int kq = lane >> 3, n4 = lane & 7, ch = lane & 7, rn = lane >> 3;
    f32x4 v[8];
    int it = gw;
    if (it < nitems) { const int kb = it / nnb, nb = it - kb * nnb; const float* s = conv_src(kind, W0, W1, nb * 32 + 4 * n4) + (size_t)(kb * 64 + kq) * nsrc;
#pragma unroll
        for (int i = 0; i < 8; ++i) v[i] = *(const f32x4*)(s + (size_t)(8 * i) * nsrc); }
    for (; it < nitems; it += NGW) {
        const int kb = it / nnb, nb = it - kb * nnb, k0 = kb * 64;
#pragma unroll
        for (int i = 0; i < 8; ++i) { const int k = k0 + kq + 8 * i; float gk = 1.f;
            if (kind == 1 || kind == 2) gk = kgain[k]; else if (kind == 3) gk = k < 1024 ? kgain[k & 127] * aux : 1.f;
            LAS float* w = scr + (kq + 8 * i) * 33 + 4 * n4; w[0] = v[i][0] * gk; w[1] = v[i][1] * gk; w[2] = v[i][2] * gk; w[3] = v[i][3] * gk; }
        const int itn = it + NGW;
        if (itn < nitems) { const int kbn = itn / nnb, nbn = itn - kbn * nnb; const float* s = conv_src(kind, W0, W1, nbn * 32 + 4 * n4) + (size_t)(kbn * 64 + kq) * nsrc;
#pragma unroll
            for (int i = 0; i < 8; ++i) v[i] = *(const f32x4*)(s + (size_t)(8 * i) * nsrc); }
        LDS_WAIT(); asm volatile("" ::: "memory");
#pragma unroll
        for (int j = 0; j < 4; ++j) { const int n = rn + 8 * j; const LAS float* r = scr + (8 * ch) * 33 + n;
            v4u o; o.x = pk2(r[0], r[33]); o.y = pk2(r[2 * 33], r[3 * 33]); o.z = pk2(r[4 * 33], r[5 * 33]); o.w = pk2(r[6 * 33], r[7 * 33]);
            *(v4u*)(WT + (size_t)(nb * 32 + n) * (K + 128) + k0 + 8 * ch) = o; }
        LDS_WAIT(); asm volatile("" ::: "memory");
    }
}
__device__ __forceinline__ void cb_row(const bf16* O, const bf16* proj, bf16* cat, bf16* catm, float lam, int row, int lane_in) {
    int lane = lane_in; asm volatile("" : "+v"(lane));
    if (row < MREAL) {
        const int h = lane >> 3, e0 = 16 * (lane & 7);
        const v4u* o1 = (const v4u*)(O + (size_t)row * D_ + (2 * h) * 128 + e0); const v4u* o2 = (const v4u*)(O + (size_t)row * D_ + (2 * h + 1) * 128 + e0);
        float d[16]; float ss = 0.f;
#pragma unroll
        for (int q = 0; q < 2; ++q) { const v4u a = o1[q], b = o2[q];
#pragma unroll
            for (int i = 0; i < 4; ++i) { d[8 * q + 2 * i] = bf_lo(a[i]) - lam * bf_lo(b[i]); d[8 * q + 2 * i + 1] = bf_hi(a[i]) - lam * bf_hi(b[i]); } }
#pragma unroll
        for (int i = 0; i < 16; ++i) ss += d[i] * d[i];
        ss += __shfl_xor(ss, 1); ss += __shfl_xor(ss, 2); ss += __shfl_xor(ss, 4);
        const float rn = 1.0f / sqrtf(ss * (1.0f / 128.0f) + SUBLN_EPS);
        v4u* op = (v4u*)(cat + (size_t)row * LDH + h * 128 + e0);
#pragma unroll
        for (int q = 0; q < 2; ++q) { v4u o; o.x = pk2(d[8 * q] * rn, d[8 * q + 1] * rn); o.y = pk2(d[8 * q + 2] * rn, d[8 * q + 3] * rn); o.z = pk2(d[8 * q + 4] * rn, d[8 * q + 5] * rn); o.w = pk2(d[8 * q + 6] * rn, d[8 * q + 7] * rn); op[q] = o; }
    }
    {
        int vrow, pos;
        if (row < MREAL) { const int b = row >> 11, t = row & 2047; vrow = b * VSEQ + 64 + t; pos = NMETA + t; } else { vrow = 48 + (row - MREAL); pos = row - MREAL; }
        const int w = 2 << (lane >> 4), cnt = (pos + 1) < w ? (pos + 1) : w;
        const bf16* zp = proj + (size_t)vrow * LDP + 3072 + 16 * lane;
        float acc[16], self[16];
#pragma unroll
        for (int i = 0; i < 16; ++i) acc[i] = 0.f;
        for (int s = 0; s < cnt; ++s) { const v4u* z = (const v4u*)(zp - (size_t)s * LDP);
#pragma unroll
            for (int q = 0; q < 2; ++q) { const v4u a = z[q];
#pragma unroll
                for (int i = 0; i < 4; ++i) { const float lo = bf_lo(a[i]), hi = bf_hi(a[i]); acc[8 * q + 2 * i] += lo; acc[8 * q + 2 * i + 1] += hi; if (s == 0) { self[8 * q + 2 * i] = lo; self[8 * q + 2 * i + 1] = hi; } } } }
        const float inv = 1.0f / (float)cnt;
        v4u* op = (v4u*)((row < MREAL ? cat + (size_t)row * LDH : catm + (size_t)(row - MREAL) * D_) + 1024 + 16 * lane);
#pragma unroll
        for (int q = 0; q < 2; ++q) { float y[8];
#pragma unroll
            for (int i = 0; i < 8; ++i) y[i] = acc[8 * q + i] * inv - self[8 * q + i];
            v4u o; o.x = pk2(y[0], y[1]); o.y = pk2(y[2], y[3]); o.z = pk2(y[4], y[5]); o.w = pk2(y[6], y[7]); op[q] = o; }
    }
}
__device__ __forceinline__ void cb_pool_item(const bf16* proj, bf16* cat, int item, int lane_in) {
    int lane = lane_in; asm volatile("" : "+v"(lane));
    const int half = item & 1, chunk = (item >> 1) & 63, b = item >> 7;
    const int c0 = 8 * (lane + 64 * half), w = 2 << (c0 >> 8);
    const bf16* zp = proj + (size_t)(b * VSEQ + 64 + 32 * chunk) * LDP + 3072 + c0;
    bf16* op = cat + (size_t)(b * NSEQ + 32 * chunk) * LDH + 1024 + c0;
    float S[8];
#pragma unroll
    for (int i = 0; i < 8; ++i) S[i] = 0.f;
    for (int s = 1; s <= w; ++s) { const v4u a = *(const v4u*)(zp - (long)s * LDP);
#pragma unroll
        for (int i = 0; i < 4; ++i) { S[2 * i] += bf_lo(a[i]); S[2 * i + 1] += bf_hi(a[i]); } }
    const float inv = 1.0f / (float)w;
#pragma unroll 1
    for (int t0 = 0; t0 < 32; t0 += 8) {
        v4u zn[8], zo[8];
#pragma unroll
        for (int t = 0; t < 8; ++t) { zn[t] = *(const v4u*)(zp + (long)(t0 + t) * LDP); zo[t] = *(const v4u*)(zp + (long)(t0 + t - w) * LDP); }
#pragma unroll
        for (int t = 0; t < 8; ++t) { float y[8];
#pragma unroll
            for (int i = 0; i < 4; ++i) { const float nl = bf_lo(zn[t][i]), nh = bf_hi(zn[t][i]);
                S[2 * i] += nl - bf_lo(zo[t][i]); S[2 * i + 1] += nh - bf_hi(zo[t][i]);
                y[2 * i] = S[2 * i] * inv - nl; y[2 * i + 1] = S[2 * i + 1] * inv - nh; }
            v4u o; o.x = pk2(y[0], y[1]); o.y = pk2(y[2], y[3]); o.z = pk2(y[4], y[5]); o.w = pk2(y[6], y[7]);
            *(v4u*)(op + (size_t)(t0 + t) * LDH) = o; }
    }
}
__device__ __forceinline__ void cb_combine8(const bf16* O, bf16* cat, float lam, int row0, int lane_in) {
    int lane = lane_in; asm volatile("" : "+v"(lane));
    const int h = lane >> 3, e0 = 16 * (lane & 7);
    const bf16* o1p = O + (size_t)row0 * D_ + (2 * h) * 128 + e0; bf16* cp = cat + (size_t)row0 * LDH + h * 128 + e0;
#pragma unroll 1
    for (int r0 = 0; r0 < 8; r0 += 4) {
        v4u a[4][2], bq[4][2];
#pragma unroll
        for (int r = 0; r < 4; ++r)
#pragma unroll
            for (int q = 0; q < 2; ++q) { a[r][q] = *((const v4u*)(o1p + (size_t)(r0 + r) * D_) + q); bq[r][q] = *((const v4u*)(o1p + (size_t)(r0 + r) * D_ + 128) + q); }
#pragma unroll
        for (int r = 0; r < 4; ++r) { float d[16]; float ss = 0.f;
#pragma unroll
            for (int q = 0; q < 2; ++q)
#pragma unroll
                for (int i = 0; i < 4; ++i) { d[8 * q + 2 * i] = bf_lo(a[r][q][i]) - lam * bf_lo(bq[r][q][i]); d[8 * q + 2 * i + 1] = bf_hi(a[r][q][i]) - lam * bf_hi(bq[r][q][i]); }
#pragma unroll
            for (int i = 0; i < 16; ++i) ss += d[i] * d[i];
            ss += __shfl_xor(ss, 1); ss += __shfl_xor(ss, 2); ss += __shfl_xor(ss, 4);
            const float rn = __builtin_amdgcn_rsqf(ss * (1.0f / 128.0f) + SUBLN_EPS);
            v4u* op = (v4u*)(cp + (size_t)(r0 + r) * LDH);
#pragma unroll
            for (int q = 0; q < 2; ++q) { v4u o; o.x = pk2(d[8 * q] * rn, d[8 * q + 1] * rn); o.y = pk2(d[8 * q + 2] * rn, d[8 * q + 3] * rn); o.z = pk2(d[8 * q + 4] * rn, d[8 * q + 5] * rn); o.w = pk2(d[8 * q + 6] * rn, d[8 * q + 7] * rn); op[q] = o; } }
    }
}
__device__ __forceinline__ void cb_meta_attn(const bf16* proj, bf16* catm, float lam, int h, int lane_in) {
    int lane = lane_in; asm volatile("" : "+v"(lane));
    const int q = lane & 15, eg = lane >> 4; const bf16* base = proj + (size_t)48 * LDP;
    float a[16];
#pragma unroll
    for (int k = 0; k < 16; ++k) a[k] = 0.f;
#pragma unroll 1
    for (int m = 0; m < 2; ++m) {
        const v4u* qp = (const v4u*)(base + (size_t)q * LDP + (2 * h + m) * 64);
        float s[16]; float mx = -INFINITY;
#pragma unroll
        for (int k = 0; k < 16; ++k) { const v4u* kp = (const v4u*)(base + (size_t)k * LDP + 1024 + (2 * h + m) * 64); float dsum = 0.f;
#pragma unroll
            for (int c = 0; c < 8; ++c) { const v4u w = kp[c], qw = qp[c];
#pragma unroll
                for (int i = 0; i < 4; ++i) dsum += bf_lo(qw[i]) * bf_lo(w[i]) + bf_hi(qw[i]) * bf_hi(w[i]); }
            s[k] = k <= q ? dsum : -INFINITY; mx = fmaxf(mx, s[k]); }
        float l = 0.f;
#pragma unroll
        for (int k = 0; k < 16; ++k) { s[k] = __builtin_amdgcn_exp2f(s[k] - mx); l += s[k]; }
        const float f = (m == 0 ? 1.0f : -lam) / l;
#pragma unroll
        for (int k = 0; k < 16; ++k) a[k] += f * s[k];
    }
    float o[32];
#pragma unroll
    for (int i = 0; i < 32; ++i) o[i] = 0.f;
#pragma unroll
    for (int k = 0; k < 16; ++k) { const v4u* vp = (const v4u*)(base + (size_t)k * LDP + 2048 + h * 128 + 32 * eg);
#pragma unroll
        for (int c = 0; c < 4; ++c) { const v4u w = vp[c];
#pragma unroll
            for (int i = 0; i < 4; ++i) { o[8 * c + 2 * i] += a[k] * bf_lo(w[i]); o[8 * c + 2 * i + 1] += a[k] * bf_hi(w[i]); } } }
    float ss = 0.f;
#pragma unroll
    for (int i = 0; i < 32; ++i) ss += o[i] * o[i];
    ss += __shfl_xor(ss, 16); ss += __shfl_xor(ss, 32);
    const float rn = 1.0f / sqrtf(ss * (1.0f / 128.0f) + SUBLN_EPS);
    v4u* op = (v4u*)(catm + (size_t)q * D_ + h * 128 + 32 * eg);
#pragma unroll
    for (int c = 0; c < 4; ++c) { v4u w; w.x = pk2(o[8 * c] * rn, o[8 * c + 1] * rn); w.y = pk2(o[8 * c + 2] * rn, o[8 * c + 3] * rn); w.z = pk2(o[8 * c + 4] * rn, o[8 * c + 5] * rn); w.w = pk2(o[8 * c + 6] * rn, o[8 * c + 7] * rn); op[c] = w; }
}
#ifndef PROBE
#define PROBE 0
#endif
#ifndef PROBE_A0
#define PROBE_A0 0
#define PROBE_A1 2
#define PROBE_B0 2
#define PROBE_B1 4
#endif
constexpr size_t WS_STAMP = 512 * 1024;
#ifndef REPEAT_MASK
#define REPEAT_MASK 0u
#endif
#define NREP(bit) (((REPEAT_MASK >> (bit)) & 1u) ? 2 : 1)
#ifndef PROBE_VAR
#define PROBE_VAR 0
#endif
namespace pg8 {
struct EpiSink { static constexpr bool PERM = true, AFTER_DRAIN = false; float* O;
    __device__ __forceinline__ void operator()(const f32x4 (&acc)[2][2][4][2], const Unit& u, int wr, int wc, int fr, int fq) const {
        f32x4 s = (f32x4){0.f, 0.f, 0.f, 0.f};
#pragma unroll
        for (int a = 0; a < 2; ++a)
#pragma unroll
            for (int b = 0; b < 2; ++b)
#pragma unroll
                for (int m = 0; m < 4; ++m)
#pragma unroll
                    for (int n = 0; n < 2; ++n) s = s + acc[a][b][m][n];
        const float t = (s[0] + s[1]) + (s[2] + s[3]);
        if (t == 1.2345e30f) O[u.pm + wr + wc + fr + fq] = t; } };
template <bool HOT> struct ProbeOrder : StaticOrder {
    __device__ bool next(int i, Unit& u) const { const bool r = StaticOrder::next(i, u); if (HOT) { u.pm = 0; u.pn = 0; } return r; } };
}
#ifndef WGM_RES
#define WGM_RES 4
#endif
#ifndef WGM_GU
#define WGM_GU 4
#endif
#ifndef WGM_IN
#define WGM_IN 4
#endif
#ifndef STAGGER
#define STAGGER 0
#endif
#ifndef MK_ONE_LAUNCH
#define MK_ONE_LAUNCH 1
#endif
typedef __attribute__((address_space(4))) const Args* KArgs;
__device__ __forceinline__ KArgs kargs() { KArgs p = (KArgs)__builtin_amdgcn_kernarg_segment_ptr(); asm volatile("" : "+s"(p)); return p; }
__global__ void __launch_bounds__(NWAVES * 64, 2) fwd_kernel(Args args_unused) {
    extern __shared__ __attribute__((aligned(16))) unsigned char lds[];
    Frame F;
    F.lds = (LAS unsigned char*)lds;
    F.MISC = (volatile LAS unsigned*)(F.lds + MISC_OFF);
    F.wave = __builtin_amdgcn_readfirstlane((int)threadIdx.x >> 6);
#define LANE() ({ int t_ = threadIdx.x; asm volatile("" : "+v"(t_)); t_ & 63; })
    F.G = gridDim.x; { const int bx = blockIdx.x; F.vcu = (F.G % 8 == 0) ? (bx % 8) * (F.G / 8) + bx / 8 : bx; }
    F.ctl = (gu32*)(kargs()->ws + WS_CTL);
    for (int u = threadIdx.x; u < (LDS_BYTES - LDSCTL_OFF) / 4; u += NWAVES * 64) ((LAS unsigned*)(F.lds + LDSCTL_OFF))[u] = 0u;
    __syncthreads();
    const int lo = kargs()->ph_lo, hi = kargs()->ph_hi;
    if (hi - lo > 1) (void)xcd_barrier_post((unsigned*)(F.ctl + CW_BAR), F.MISC + 8);
#ifndef PH_MASK
#define PH_MASK 0xFFFFFFFFu
#endif
#define EN(bit) ((PH_MASK >> (bit)) & 1u)
#define IN(k) (lo <= (k) && (k) < hi)
#define STAMP(i) do { if (PROBE && blockIdx.x == 0 && threadIdx.x == 0) ((unsigned long long*)(kargs()->ws + WS_STAMP))[(i)] = __builtin_amdgcn_s_memrealtime(); } while (0)
#define SEAM(k) do { STAMP(1 + 2 * (k)); if (IN(k) && IN((k) + 1)) { XcdBarrier bar_; bar_.bar = (unsigned*)(kargs()->ws + WS_CTL) + CW_BAR; bar_.x = xb_xcc_id(); bar_.st = F.MISC + 8; xcd_barrier(bar_); } STAMP(2 + 2 * (k)); } while (0)
#define WSP(T, off) ((T*)(A->ws + (off)))
    const int gw = F.vcu * NWAVES + F.wave, NGW = F.G * NWAVES;
    STAMP(0);

    _Pragma("unroll 1") for (int rp = 0; rp < NREP(0); ++rp) {
    if (EN(0) && IN(0)) { const KArgs A = kargs(); const int lane = LANE(); float* RC = WSP(float, WS_ROPE); float* RS = RC + NPOS * 32;
        for (int it = gw; it < 4096; it += NGW) fold_item(A->in[7], A->in[13], A->in[14], A->in[6], (bf16*)(A->ws + WS_WTS + (size_t)(it >> 10) * WL_BYTES + WL_IN), it, lane);
        for (int r = gw; r < MREAL; r += NGW) hinit_row(A->in[0], A->in[1], WSP(bf16, WS_HB), H16_MASTER ? WSP(bf16, WS_H16) : nullptr, WSP(float, WS_SSQ), r, lane);
        for (int j = gw; j < NMETA; j += NGW) hinit_meta(A->in[1], WSP(bf16, WS_HM), H16_MASTER ? WSP(bf16, WS_HM16) : nullptr, WSP(float, WS_SSQM), j, lane);
        for (int i = gw * 64 + lane; i < NPOS * 32; i += NGW * 64) { const int pos = i >> 5, f = i & 31;
            const float inv = 1.0f / powf(10000.0f, (float)(2 * f) / 64.0f); const float ang = (float)pos * inv; RC[i] = cosf(ang); RS[i] = sinf(ang); }
    }
    STAMP(1); STAMP(2); }
    _Pragma("unroll 1") for (int rp = 0; rp < NREP(1); ++rp) {
    if (EN(1) && IN(1)) { const KArgs A = kargs(); const int lane = LANE(); unsigned char* ws = A->ws;
        LAS float* scr = (LAS float*)(F.lds + RING_OFF) + F.wave * (64 * 33);
#pragma unroll 1
        for (int L = 0; L < DEPTH; ++L) { unsigned char* wl = ws + WS_WTS + (size_t)L * WL_BYTES; const size_t oFF = (size_t)L * D_ * FF_;
            conv_run(1, A->in[3] + oFF, A->in[4] + oFF, A->in[2] + L * D_, 0.f, (bf16*)(wl + WL_GU1), D_, FF_, 2 * FF_ / 32, (2 * FF_ / 32) * (D_ / 64), gw, NGW, lane, scr);
            conv_run(0, A->in[5] + oFF, nullptr, nullptr, 0.f, (bf16*)(wl + WL_D1), FF_, D_, D_ / 32, (D_ / 32) * (FF_ / 64), gw, NGW, lane, scr);
            conv_run(2, A->in[7] + (size_t)L * D_ * INW, nullptr, A->in[6] + L * D_, 0.f, (bf16*)(wl + WL_IN), D_, INW, 3072 / 32, (3072 / 32) * (D_ / 64), gw, NGW, lane, scr);
            conv_run(3, A->in[15] + (size_t)L * D_ * D_, nullptr, A->in[12] + L * 128, 1.0f - A->lam_init[L], (bf16*)(wl + WL_OUT), D_, D_, D_ / 32, (D_ / 32) * (D_ / 64), gw, NGW, lane, scr);
            conv_run(1, A->in[17] + oFF, A->in[18] + oFF, A->in[16] + L * D_, 0.f, (bf16*)(wl + WL_GU2), D_, FF_, 2 * FF_ / 32, (2 * FF_ / 32) * (D_ / 64), gw, NGW, lane, scr);
            conv_run(0, A->in[19] + oFF, nullptr, nullptr, 0.f, (bf16*)(wl + WL_D2), FF_, D_, D_ / 32, (D_ / 32) * (FF_ / 64), gw, NGW, lane, scr);
        }
    }
    SEAM(1); }
#define LAYER() const int L = Lc
#define WL(off) ((const bf16*)(A->ws + WS_WTS + (size_t)L * WL_BYTES + (off)))
#define SSQ(k) ((float*)(A->ws + WS_SSQ + (size_t)(3 * L + (k)) * SSQ_SET))
#define SSQM(k) ((float*)(A->ws + WS_SSQM + (size_t)(3 * L + (k)) * SSQM_SET))
#define THIN_ARGS F.vcu, F.G, F.wave, LANE(), (LAS float*)(F.lds + RING_OFF)
    { constexpr int Lc = 0;
        const int pb = 2 + 8 * Lc;
        _Pragma("unroll 1") for (int rp = 0; rp < NREP(2); ++rp) {
        if (EN(2) && IN(pb + 0)) { const KArgs A = kargs(); LAYER(); if (!rp) thin_gu<!H16_MASTER>(WSP(bf16, WS_HM), WL(WL_GU1), SSQM(0), WSP(bf16, WS_MIDM), THIN_ARGS); pg8::Gemm g{WSP(bf16, WS_HB), WL(WL_GU1), MREAL, 2 * FF_, D_, LDH, LDH}; pg8::StaticOrder S; S.init(MREAL, 2 * FF_, F.G, (int)blockIdx.x, WGM_GU);
#if PROBE_VAR >= 6
            if (rp) { pg8::EpiSwiGLUT<PROBE_VAR> E2{WSP(bf16, WS_MID), SSQ(0)}; pg8::gemm_phase<pg8::EpiSwiGLUT<PROBE_VAR>, pg8::StaticOrder, true, true, !H16_MASTER>(F.lds + RING_OFF, g, S, E2); } else
#elif PROBE_VAR == 1 || PROBE_VAR == 2
            if (rp) { pg8::ProbeOrder<PROBE_VAR == 2> S2; S2.init(MREAL, 2 * FF_, F.G, (int)blockIdx.x); pg8::EpiSink E2{WSP(float, WS_SSQ)}; pg8::gemm_phase<pg8::EpiSink, pg8::ProbeOrder<PROBE_VAR == 2>, true, true, !H16_MASTER>(F.lds + RING_OFF, g, S2, E2); } else
#endif
            { pg8::EpiSwiGLU E{WSP(bf16, WS_MID), SSQ(0)}; pg8::gemm_phase<pg8::EpiSwiGLU, pg8::StaticOrder, true, true, !H16_MASTER>(F.lds + RING_OFF, g, S, E); } }
        SEAM(pb + 0); }
        _Pragma("unroll 1") for (int rp = 0; rp < NREP(3); ++rp) {
        if (EN(3) && IN(pb + 1)) { const KArgs A = kargs(); LAYER(); if (!rp) thin_resid<22>(WSP(bf16, WS_MIDM), WL(WL_D1), FF_, WSP(bf16, WS_HM), H16_MASTER ? WSP(bf16, WS_HM16) : nullptr, SSQM(1), 0.5f, THIN_ARGS); pg8::Gemm g{WSP(bf16, WS_MID), WL(WL_D1), MREAL, D_, FF_, LDM, LDM}; pg8::StaggerOrder S; S.init2(MREAL, D_, FF_, F.G, (int)blockIdx.x, STAGGER ? (int)((blockIdx.x >> 3) & 3) : 0, WGM_RES);
#if PROBE_VAR >= 3 && PROBE_VAR <= 5
            if (rp) { pg8::EpiResidT<PROBE_VAR> E2{WSP(bf16, WS_HB), SSQ(1), 0.f, F.lds + XR_OFF, (bf16*)A->out, H16_MASTER ? WSP(bf16, WS_H16) : nullptr, 0}; pg8::gemm_phase<pg8::EpiResidT<PROBE_VAR>, pg8::StaggerOrder, true, true>(F.lds + RING_OFF, g, S, E2); } else
#elif PROBE_VAR
            if (rp) { pg8::ProbeOrder<PROBE_VAR == 2> S2; S2.init(MREAL, D_, F.G, (int)blockIdx.x); pg8::EpiSink E2{WSP(float, WS_SSQ)}; pg8::gemm_phase<pg8::EpiSink, pg8::ProbeOrder<PROBE_VAR == 2>, true, true>(F.lds + RING_OFF, g, S2, E2); } else
#endif
            { pg8::EpiResid E{WSP(bf16, WS_HB), SSQ(1), rp ? 0.f : 0.5f, F.lds + XR_OFF, nullptr, H16_MASTER ? WSP(bf16, WS_H16) : nullptr, 0}; pg8::gemm_phase<pg8::EpiResid, pg8::StaggerOrder, true, true>(F.lds + RING_OFF, g, S, E); } }
        SEAM(pb + 1); }
        _Pragma("unroll 1") for (int rp = 0; rp < NREP(4); ++rp) {
        if (EN(4) && IN(pb + 2)) { const KArgs A = kargs(); LAYER(); if (!rp) thin_proj<!H16_MASTER>(WSP(bf16, WS_HM), WL(WL_IN), SSQM(1), WSP(bf16, WS_PROJ), WSP(float, WS_ROPE), WSP(float, WS_ROPE) + NPOS * 32, THIN_ARGS); pg8::Gemm g{WSP(bf16, WS_HB), WL(WL_IN), MREAL, INW, D_, LDH, LDH}; pg8::StaticOrder S; S.init(MREAL, INW, F.G, (int)blockIdx.x, WGM_IN);
            pg8::EpiProj E{WSP(bf16, WS_PROJ), SSQ(1), WSP(float, WS_ROPE), WSP(float, WS_ROPE) + NPOS * 32}; pg8::gemm_phase<pg8::EpiProj, pg8::StaticOrder, true, true, !H16_MASTER>(F.lds + RING_OFF, g, S, E); }
        SEAM(pb + 2); }
        _Pragma("unroll 1") for (int rp = 0; rp < NREP(5); ++rp) {
        if (EN(5) && IN(pb + 3)) { const KArgs A = kargs(); LAYER(); const bf16* PROJ = WSP(bf16, WS_PROJ); bf16* CAT = WSP(bf16, WS_CAT);
            const int ln_ = LANE(); const float sa = wave_sum(A->in[8][L * 64 + ln_] * A->in[9][L * 64 + ln_]), sb = wave_sum(A->in[10][L * 64 + ln_] * A->in[11][L * 64 + ln_]);
            const float lam = expf(sa) - expf(sb) + A->lam_init[L];
            for (int v = F.vcu; v < 256; v += F.G) { const int bh = v >> 1, sx = v & 1, b = bh >> 3, h = bh & 7;
#pragma unroll 1
                for (int i = 0; i < 8; ++i) { const int m = i & 1, qs = i >> 1;
                    const int qb = sx == 0 ? (qs == 0 ? 0 : qs == 1 ? 7 : qs == 2 ? 1 : 6) : (qs == 0 ? 2 : qs == 1 ? 5 : qs == 2 ? 3 : 4);
                    const attn_body::bf16* P = (const attn_body::bf16*)PROJ + (size_t)b * VSEQ * LDP;
                    attn_body::attn_unit<8>(qb, P + (size_t)(64 + 256 * qb) * LDP + (2 * h + m) * 64, P + 1024 + (2 * h + m) * 64, P + 2048 + h * 128,
                                            (attn_body::bf16*)CAT + (size_t)(b * NSEQ + 256 * qb) * LDH + h * 128, (char*)lds + RING_OFF, m, lam, (float*)(A->ws + WS_OSCR) + (size_t)v * 32768); } }
            { bf16* CATM = WSP(bf16, WS_CATM); const int lane = LANE();
              if (gw < NHEADS && NGW > 64) cb_meta_attn(PROJ, CATM, lam, gw, lane);
              else { const int w0 = NGW > 64 ? gw - NHEADS : gw, nw = NGW > 64 ? NGW - NHEADS : NGW;
                if (NGW <= 64) for (int it = gw; it < NHEADS; it += NGW) cb_meta_attn(PROJ, CATM, lam, it, lane);
                for (int it = w0; it < NMETA + NBATCH * 128; it += nw) {
                    if (it < NMETA) cb_row((const bf16*)nullptr, PROJ, CAT, CATM, lam, MREAL + it, lane);
                    else cb_pool_item(PROJ, CAT, it - NMETA, lane); } } }
        }
        SEAM(pb + 3); }
        _Pragma("unroll 1") for (int rp = 0; rp < NREP(7); ++rp) {
        if (EN(7) && IN(pb + 5)) { const KArgs A = kargs(); LAYER(); if (!rp) thin_resid<8>(WSP(bf16, WS_CATM), WL(WL_OUT), D_, WSP(bf16, WS_HM), H16_MASTER ? WSP(bf16, WS_HM16) : nullptr, SSQM(2), 1.0f, THIN_ARGS); pg8::Gemm g{WSP(bf16, WS_CAT), WL(WL_OUT), MREAL, D_, D_, LDH, LDH}; pg8::StaggerOrder S; S.init2(MREAL, D_, D_, F.G, (int)blockIdx.x, STAGGER ? (int)((blockIdx.x >> 3) & 3) : 0, WGM_RES);
            pg8::EpiResid E{WSP(bf16, WS_HB), SSQ(2), rp ? 0.f : 1.0f, F.lds + XR_OFF, nullptr, H16_MASTER ? WSP(bf16, WS_H16) : nullptr, 0}; pg8::gemm_phase<pg8::EpiResid, pg8::StaggerOrder, true, true>(F.lds + RING_OFF, g, S, E); }
        SEAM(pb + 5); }
        _Pragma("unroll 1") for (int rp = 0; rp < NREP(8); ++rp) {
        if (EN(8) && IN(pb + 6)) { const KArgs A = kargs(); LAYER(); if (!rp) thin_gu<!H16_MASTER>(WSP(bf16, WS_HM), WL(WL_GU2), SSQM(2), WSP(bf16, WS_MIDM), THIN_ARGS); pg8::Gemm g{WSP(bf16, WS_HB), WL(WL_GU2), MREAL, 2 * FF_, D_, LDH, LDH}; pg8::StaticOrder S; S.init(MREAL, 2 * FF_, F.G, (int)blockIdx.x, WGM_GU);
            pg8::EpiSwiGLU E{WSP(bf16, WS_MID), SSQ(2)}; pg8::gemm_phase<pg8::EpiSwiGLU, pg8::StaticOrder, true, true, !H16_MASTER>(F.lds + RING_OFF, g, S, E); }
        SEAM(pb + 6); }
        _Pragma("unroll 1") for (int rp = 0; rp < NREP(9); ++rp) {
        if (EN(9) && IN(pb + 7)) { const KArgs A = kargs(); LAYER(); if (!rp) thin_resid<22>(WSP(bf16, WS_MIDM), WL(WL_D2), FF_, WSP(bf16, WS_HM), H16_MASTER ? WSP(bf16, WS_HM16) : nullptr, SSQM(3), 0.5f, THIN_ARGS); pg8::Gemm g{WSP(bf16, WS_MID), WL(WL_D2), MREAL, D_, FF_, LDM, LDM}; pg8::StaggerOrder S; S.init2(MREAL, D_, FF_, F.G, (int)blockIdx.x, STAGGER ? (int)((blockIdx.x >> 3) & 3) : 0, WGM_RES);
            pg8::EpiResid E{WSP(bf16, WS_HB), SSQ(3), rp ? 0.f : 0.5f, F.lds + XR_OFF, nullptr, H16_MASTER ? WSP(bf16, WS_H16) : nullptr, (H16_MASTER && L == DEPTH - 1) ? 1 : 0}; pg8::gemm_phase<pg8::EpiResid, pg8::StaggerOrder, true, true>(F.lds + RING_OFF, g, S, E); }
        SEAM(pb + 7); }
    }
    { constexpr int Lc = 1;
        const int pb = 2 + 8 * Lc;
        _Pragma("unroll 1") for (int rp = 0; rp < NREP(2); ++rp) {
        if (EN(2) && IN(pb + 0)) { const KArgs A = kargs(); LAYER(); if (!rp) thin_gu<!H16_MASTER>(WSP(bf16, WS_HM), WL(WL_GU1), SSQM(0), WSP(bf16, WS_MIDM), THIN_ARGS); pg8::Gemm g{WSP(bf16, WS_HB), WL(WL_GU1), MREAL, 2 * FF_, D_, LDH, LDH}; pg8::StaticOrder S; S.init(MREAL, 2 * FF_, F.G, (int)blockIdx.x, WGM_GU);
#if PROBE_VAR >= 6
            if (rp) { pg8::EpiSwiGLUT<PROBE_VAR> E2{WSP(bf16, WS_MID), SSQ(0)}; pg8::gemm_phase<pg8::EpiSwiGLUT<PROBE_VAR>, pg8::StaticOrder, true, true, !H16_MASTER>(F.lds + RING_OFF, g, S, E2); } else
#elif PROBE_VAR == 1 || PROBE_VAR == 2
            if (rp) { pg8::ProbeOrder<PROBE_VAR == 2> S2; S2.init(MREAL, 2 * FF_, F.G, (int)blockIdx.x); pg8::EpiSink E2{WSP(float, WS_SSQ)}; pg8::gemm_phase<pg8::EpiSink, pg8::ProbeOrder<PROBE_VAR == 2>, true, true, !H16_MASTER>(F.lds + RING_OFF, g, S2, E2); } else
#endif
            { pg8::EpiSwiGLU E{WSP(bf16, WS_MID), SSQ(0)}; pg8::gemm_phase<pg8::EpiSwiGLU, pg8::StaticOrder, true, true, !H16_MASTER>(F.lds + RING_OFF, g, S, E); } }
        SEAM(pb + 0); }
        _Pragma("unroll 1") for (int rp = 0; rp < NREP(3); ++rp) {
        if (EN(3) && IN(pb + 1)) { const KArgs A = kargs(); LAYER(); if (!rp) thin_resid<22>(WSP(bf16, WS_MIDM), WL(WL_D1), FF_, WSP(bf16, WS_HM), H16_MASTER ? WSP(bf16, WS_HM16) : nullptr, SSQM(1), 0.5f, THIN_ARGS); pg8::Gemm g{WSP(bf16, WS_MID), WL(WL_D1), MREAL, D_, FF_, LDM, LDM}; pg8::StaggerOrder S; S.init2(MREAL, D_, FF_, F.G, (int)blockIdx.x, STAGGER ? (int)((blockIdx.x >> 3) & 3) : 0, WGM_RES);
#if PROBE_VAR >= 3 && PROBE_VAR <= 5
            if (rp) { pg8::EpiResidT<PROBE_VAR> E2{WSP(bf16, WS_HB), SSQ(1), 0.f, F.lds + XR_OFF, (bf16*)A->out, H16_MASTER ? WSP(bf16, WS_H16) : nullptr, 0}; pg8::gemm_phase<pg8::EpiResidT<PROBE_VAR>, pg8::StaggerOrder, true, true>(F.lds + RING_OFF, g, S, E2); } else
#elif PROBE_VAR
            if (rp) { pg8::ProbeOrder<PROBE_VAR == 2> S2; S2.init(MREAL, D_, F.G, (int)blockIdx.x); pg8::EpiSink E2{WSP(float, WS_SSQ)}; pg8::gemm_phase<pg8::EpiSink, pg8::ProbeOrder<PROBE_VAR == 2>, true, true>(F.lds + RING_OFF, g, S2, E2); } else
#endif
            { pg8::EpiResid E{WSP(bf16, WS_HB), SSQ(1), rp ? 0.f : 0.5f, F.lds + XR_OFF, nullptr, H16_MASTER ? WSP(bf16, WS_H16) : nullptr, 0}; pg8::gemm_phase<pg8::EpiResid, pg8::StaggerOrder, true, true>(F.lds + RING_OFF, g, S, E); } }
        SEAM(pb + 1); }
        _Pragma("unroll 1") for (int rp = 0; rp < NREP(4); ++rp) {
        if (EN(4) && IN(pb + 2)) { const KArgs A = kargs(); LAYER(); if (!rp) thin_proj<!H16_MASTER>(WSP(bf16, WS_HM), WL(WL_IN), SSQM(1), WSP(bf16, WS_PROJ), WSP(float, WS_ROPE), WSP(float, WS_ROPE) + NPOS * 32, THIN_ARGS); pg8::Gemm g{WSP(bf16, WS_HB), WL(WL_IN), MREAL, INW, D_, LDH, LDH}; pg8::StaticOrder S; S.init(MREAL, INW, F.G, (int)blockIdx.x, WGM_IN);
            pg8::EpiProj E{WSP(bf16, WS_PROJ), SSQ(1), WSP(float, WS_ROPE), WSP(float, WS_ROPE) + NPOS * 32}; pg8::gemm_phase<pg8::EpiProj, pg8::StaticOrder, true, true, !H16_MASTER>(F.lds + RING_OFF, g, S, E); }
        SEAM(pb + 2); }
        _Pragma("unroll 1") for (int rp = 0; rp < NREP(5); ++rp) {
        if (EN(5) && IN(pb + 3)) { const KArgs A = kargs(); LAYER(); const bf16* PROJ = WSP(bf16, WS_PROJ); bf16* CAT = WSP(bf16, WS_CAT);
            const int ln_ = LANE(); const float sa = wave_sum(A->in[8][L * 64 + ln_] * A->in[9][L * 64 + ln_]), sb = wave_sum(A->in[10][L * 64 + ln_] * A->in[11][L * 64 + ln_]);
            const float lam = expf(sa) - expf(sb) + A->lam_init[L];
            for (int v = F.vcu; v < 256; v += F.G) { const int bh = v >> 1, sx = v & 1, b = bh >> 3, h = bh & 7;
#pragma unroll 1
                for (int i = 0; i < 8; ++i) { const int m = i & 1, qs = i >> 1;
                    const int qb = sx == 0 ? (qs == 0 ? 0 : qs == 1 ? 7 : qs == 2 ? 1 : 6) : (qs == 0 ? 2 : qs == 1 ? 5 : qs == 2 ? 3 : 4);
                    const attn_body::bf16* P = (const attn_body::bf16*)PROJ + (size_t)b * VSEQ * LDP;
                    attn_body::attn_unit<8>(qb, P + (size_t)(64 + 256 * qb) * LDP + (2 * h + m) * 64, P + 1024 + (2 * h + m) * 64, P + 2048 + h * 128,
                                            (attn_body::bf16*)CAT + (size_t)(b * NSEQ + 256 * qb) * LDH + h * 128, (char*)lds + RING_OFF, m, lam, (float*)(A->ws + WS_OSCR) + (size_t)v * 32768); } }
            { bf16* CATM = WSP(bf16, WS_CATM); const int lane = LANE();
              if (gw < NHEADS && NGW > 64) cb_meta_attn(PROJ, CATM, lam, gw, lane);
              else { const int w0 = NGW > 64 ? gw - NHEADS : gw, nw = NGW > 64 ? NGW - NHEADS : NGW;
                if (NGW <= 64) for (int it = gw; it < NHEADS; it += NGW) cb_meta_attn(PROJ, CATM, lam, it, lane);
                for (int it = w0; it < NMETA + NBATCH * 128; it += nw) {
                    if (it < NMETA) cb_row((const bf16*)nullptr, PROJ, CAT, CATM, lam, MREAL + it, lane);
                    else cb_pool_item(PROJ, CAT, it - NMETA, lane); } } }
        }
        SEAM(pb + 3); }
        _Pragma("unroll 1") for (int rp = 0; rp < NREP(7); ++rp) {
        if (EN(7) && IN(pb + 5)) { const KArgs A = kargs(); LAYER(); if (!rp) thin_resid<8>(WSP(bf16, WS_CATM), WL(WL_OUT), D_, WSP(bf16, WS_HM), H16_MASTER ? WSP(bf16, WS_HM16) : nullptr, SSQM(2), 1.0f, THIN_ARGS); pg8::Gemm g{WSP(bf16, WS_CAT), WL(WL_OUT), MREAL, D_, D_, LDH, LDH}; pg8::StaggerOrder S; S.init2(MREAL, D_, D_, F.G, (int)blockIdx.x, STAGGER ? (int)((blockIdx.x >> 3) & 3) : 0, WGM_RES);
            pg8::EpiResid E{WSP(bf16, WS_HB), SSQ(2), rp ? 0.f : 1.0f, F.lds + XR_OFF, nullptr, H16_MASTER ? WSP(bf16, WS_H16) : nullptr, 0}; pg8::gemm_phase<pg8::EpiResid, pg8::StaggerOrder, true, true>(F.lds + RING_OFF, g, S, E); }
        SEAM(pb + 5); }
        _Pragma("unroll 1") for (int rp = 0; rp < NREP(8); ++rp) {
        if (EN(8) && IN(pb + 6)) { const KArgs A = kargs(); LAYER(); if (!rp) thin_gu<!H16_MASTER>(WSP(bf16, WS_HM), WL(WL_GU2), SSQM(2), WSP(bf16, WS_MIDM), THIN_ARGS); pg8::Gemm g{WSP(bf16, WS_HB), WL(WL_GU2), MREAL, 2 * FF_, D_, LDH, LDH}; pg8::StaticOrder S; S.init(MREAL, 2 * FF_, F.G, (int)blockIdx.x, WGM_GU);
            pg8::EpiSwiGLU E{WSP(bf16, WS_MID), SSQ(2)}; pg8::gemm_phase<pg8::EpiSwiGLU, pg8::StaticOrder, true, true, !H16_MASTER>(F.lds + RING_OFF, g, S, E); }
        SEAM(pb + 6); }
        _Pragma("unroll 1") for (int rp = 0; rp < NREP(9); ++rp) {
        if (EN(9) && IN(pb + 7)) { const KArgs A = kargs(); LAYER(); if (!rp) thin_resid<22>(WSP(bf16, WS_MIDM), WL(WL_D2), FF_, WSP(bf16, WS_HM), H16_MASTER ? WSP(bf16, WS_HM16) : nullptr, SSQM(3), 0.5f, THIN_ARGS); pg8::Gemm g{WSP(bf16, WS_MID), WL(WL_D2), MREAL, D_, FF_, LDM, LDM}; pg8::StaggerOrder S; S.init2(MREAL, D_, FF_, F.G, (int)blockIdx.x, STAGGER ? (int)((blockIdx.x >> 3) & 3) : 0, WGM_RES);
            pg8::EpiResid E{WSP(bf16, WS_HB), SSQ(3), rp ? 0.f : 0.5f, F.lds + XR_OFF, nullptr, H16_MASTER ? WSP(bf16, WS_H16) : nullptr, (H16_MASTER && L == DEPTH - 1) ? 1 : 0}; pg8::gemm_phase<pg8::EpiResid, pg8::StaggerOrder, true, true>(F.lds + RING_OFF, g, S, E); }
        SEAM(pb + 7); }
    }
    { constexpr int Lc = 2;
        const int pb = 2 + 8 * Lc;
        _Pragma("unroll 1") for (int rp = 0; rp < NREP(2); ++rp) {
        if (EN(2) && IN(pb + 0)) { const KArgs A = kargs(); LAYER(); if (!rp) thin_gu<!H16_MASTER>(WSP(bf16, WS_HM), WL(WL_GU1), SSQM(0), WSP(bf16, WS_MIDM), THIN_ARGS); pg8::Gemm g{WSP(bf16, WS_HB), WL(WL_GU1), MREAL, 2 * FF_, D_, LDH, LDH}; pg8::StaticOrder S; S.init(MREAL, 2 * FF_, F.G, (int)blockIdx.x, WGM_GU);
#if PROBE_VAR >= 6
            if (rp) { pg8::EpiSwiGLUT<PROBE_VAR> E2{WSP(bf16, WS_MID), SSQ(0)}; pg8::gemm_phase<pg8::EpiSwiGLUT<PROBE_VAR>, pg8::StaticOrder, true, true, !H16_MASTER>(F.lds + RING_OFF, g, S, E2); } else
#elif PROBE_VAR == 1 || PROBE_VAR == 2
            if (rp) { pg8::ProbeOrder<PROBE_VAR == 2> S2; S2.init(MREAL, 2 * FF_, F.G, (int)blockIdx.x); pg8::EpiSink E2{WSP(float, WS_SSQ)}; pg8::gemm_phase<pg8::EpiSink, pg8::ProbeOrder<PROBE_VAR == 2>, true, true, !H16_MASTER>(F.lds + RING_OFF, g, S2, E2); } else
#endif
            { pg8::EpiSwiGLU E{WSP(bf16, WS_MID), SSQ(0)}; pg8::gemm_phase<pg8::EpiSwiGLU, pg8::StaticOrder, true, true, !H16_MASTER>(F.lds + RING_OFF, g, S, E); } }
        SEAM(pb + 0); }
        _Pragma("unroll 1") for (int rp = 0; rp < NREP(3); ++rp) {
        if (EN(3) && IN(pb + 1)) { const KArgs A = kargs(); LAYER(); if (!rp) thin_resid<22>(WSP(bf16, WS_MIDM), WL(WL_D1), FF_, WSP(bf16, WS_HM), H16_MASTER ? WSP(bf16, WS_HM16) : nullptr, SSQM(1), 0.5f, THIN_ARGS); pg8::Gemm g{WSP(bf16, WS_MID), WL(WL_D1), MREAL, D_, FF_, LDM, LDM}; pg8::StaggerOrder S; S.init2(MREAL, D_, FF_, F.G, (int)blockIdx.x, STAGGER ? (int)((blockIdx.x >> 3) & 3) : 0, WGM_RES);
#if PROBE_VAR >= 3 && PROBE_VAR <= 5
            if (rp) { pg8::EpiResidT<PROBE_VAR> E2{WSP(bf16, WS_HB), SSQ(1), 0.f, F.lds + XR_OFF, (bf16*)A->out, H16_MASTER ? WSP(bf16, WS_H16) : nullptr, 0}; pg8::gemm_phase<pg8::EpiResidT<PROBE_VAR>, pg8::StaggerOrder, true, true>(F.lds + RING_OFF, g, S, E2); } else
#elif PROBE_VAR
            if (rp) { pg8::ProbeOrder<PROBE_VAR == 2> S2; S2.init(MREAL, D_, F.G, (int)blockIdx.x); pg8::EpiSink E2{WSP(float, WS_SSQ)}; pg8::gemm_phase<pg8::EpiSink, pg8::ProbeOrder<PROBE_VAR == 2>, true, true>(F.lds + RING_OFF, g, S2, E2); } else
#endif
            { pg8::EpiResid E{WSP(bf16, WS_HB), SSQ(1), rp ? 0.f : 0.5f, F.lds + XR_OFF, nullptr, H16_MASTER ? WSP(bf16, WS_H16) : nullptr, 0}; pg8::gemm_phase<pg8::EpiResid, pg8::StaggerOrder, true, true>(F.lds + RING_OFF, g, S, E); } }
        SEAM(pb + 1); }
        _Pragma("unroll 1") for (int rp = 0; rp < NREP(4); ++rp) {
        if (EN(4) && IN(pb + 2)) { const KArgs A = kargs(); LAYER(); if (!rp) thin_proj<!H16_MASTER>(WSP(bf16, WS_HM), WL(WL_IN), SSQM(1), WSP(bf16, WS_PROJ), WSP(float, WS_ROPE), WSP(float, WS_ROPE) + NPOS * 32, THIN_ARGS); pg8::Gemm g{WSP(bf16, WS_HB), WL(WL_IN), MREAL, INW, D_, LDH, LDH}; pg8::StaticOrder S; S.init(MREAL, INW, F.G, (int)blockIdx.x, WGM_IN);
            pg8::EpiProj E{WSP(bf16, WS_PROJ), SSQ(1), WSP(float, WS_ROPE), WSP(float, WS_ROPE) + NPOS * 32}; pg8::gemm_phase<pg8::EpiProj, pg8::StaticOrder, true, true, !H16_MASTER>(F.lds + RING_OFF, g, S, E); }
        SEAM(pb + 2); }
        _Pragma("unroll 1") for (int rp = 0; rp < NREP(5); ++rp) {
        if (EN(5) && IN(pb + 3)) { const KArgs A = kargs(); LAYER(); const bf16* PROJ = WSP(bf16, WS_PROJ); bf16* CAT = WSP(bf16, WS_CAT);
            const int ln_ = LANE(); const float sa = wave_sum(A->in[8][L * 64 + ln_] * A->in[9][L * 64 + ln_]), sb = wave_sum(A->in[10][L * 64 + ln_] * A->in[11][L * 64 + ln_]);
            const float lam = expf(sa) - expf(sb) + A->lam_init[L];
            for (int v = F.vcu; v < 256; v += F.G) { const int bh = v >> 1, sx = v & 1, b = bh >> 3, h = bh & 7;
#pragma unroll 1
                for (int i = 0; i < 8; ++i) { const int m = i & 1, qs = i >> 1;
                    const int qb = sx == 0 ? (qs == 0 ? 0 : qs == 1 ? 7 : qs == 2 ? 1 : 6) : (qs == 0 ? 2 : qs == 1 ? 5 : qs == 2 ? 3 : 4);
                    const attn_body::bf16* P = (const attn_body::bf16*)PROJ + (size_t)b * VSEQ * LDP;
                    attn_body::attn_unit<8>(qb, P + (size_t)(64 + 256 * qb) * LDP + (2 * h + m) * 64, P + 1024 + (2 * h + m) * 64, P + 2048 + h * 128,
                                            (attn_body::bf16*)CAT + (size_t)(b * NSEQ + 256 * qb) * LDH + h * 128, (char*)lds + RING_OFF, m, lam, (float*)(A->ws + WS_OSCR) + (size_t)v * 32768); } }
            { bf16* CATM = WSP(bf16, WS_CATM); const int lane = LANE();
              if (gw < NHEADS && NGW > 64) cb_meta_attn(PROJ, CATM, lam, gw, lane);
              else { const int w0 = NGW > 64 ? gw - NHEADS : gw, nw = NGW > 64 ? NGW - NHEADS : NGW;
                if (NGW <= 64) for (int it = gw; it < NHEADS; it += NGW) cb_meta_attn(PROJ, CATM, lam, it, lane);
                for (int it = w0; it < NMETA + NBATCH * 128; it += nw) {
                    if (it < NMETA) cb_row((const bf16*)nullptr, PROJ, CAT, CATM, lam, MREAL + it, lane);
                    else cb_pool_item(PROJ, CAT, it - NMETA, lane); } } }
        }
        SEAM(pb + 3); }
        _Pragma("unroll 1") for (int rp = 0; rp < NREP(7); ++rp) {
        if (EN(7) && IN(pb + 5)) { const KArgs A = kargs(); LAYER(); if (!rp) thin_resid<8>(WSP(bf16, WS_CATM), WL(WL_OUT), D_, WSP(bf16, WS_HM), H16_MASTER ? WSP(bf16, WS_HM16) : nullptr, SSQM(2), 1.0f, THIN_ARGS); pg8::Gemm g{WSP(bf16, WS_CAT), WL(WL_OUT), MREAL, D_, D_, LDH, LDH}; pg8::StaggerOrder S; S.init2(MREAL, D_, D_, F.G, (int)blockIdx.x, STAGGER ? (int)((blockIdx.x >> 3) & 3) : 0, WGM_RES);
            pg8::EpiResid E{WSP(bf16, WS_HB), SSQ(2), rp ? 0.f : 1.0f, F.lds + XR_OFF, nullptr, H16_MASTER ? WSP(bf16, WS_H16) : nullptr, 0}; pg8::gemm_phase<pg8::EpiResid, pg8::StaggerOrder, true, true>(F.lds + RING_OFF, g, S, E); }
        SEAM(pb + 5); }
        _Pragma("unroll 1") for (int rp = 0; rp < NREP(8); ++rp) {
        if (EN(8) && IN(pb + 6)) { const KArgs A = kargs(); LAYER(); if (!rp) thin_gu<!H16_MASTER>(WSP(bf16, WS_HM), WL(WL_GU2), SSQM(2), WSP(bf16, WS_MIDM), THIN_ARGS); pg8::Gemm g{WSP(bf16, WS_HB), WL(WL_GU2), MREAL, 2 * FF_, D_, LDH, LDH}; pg8::StaticOrder S; S.init(MREAL, 2 * FF_, F.G, (int)blockIdx.x, WGM_GU);
            pg8::EpiSwiGLU E{WSP(bf16, WS_MID), SSQ(2)}; pg8::gemm_phase<pg8::EpiSwiGLU, pg8::StaticOrder, true, true, !H16_MASTER>(F.lds + RING_OFF, g, S, E); }
        SEAM(pb + 6); }
        _Pragma("unroll 1") for (int rp = 0; rp < NREP(9); ++rp) {
        if (EN(9) && IN(pb + 7)) { const KArgs A = kargs(); LAYER(); if (!rp) thin_resid<22>(WSP(bf16, WS_MIDM), WL(WL_D2), FF_, WSP(bf16, WS_HM), H16_MASTER ? WSP(bf16, WS_HM16) : nullptr, SSQM(3), 0.5f, THIN_ARGS); pg8::Gemm g{WSP(bf16, WS_MID), WL(WL_D2), MREAL, D_, FF_, LDM, LDM}; pg8::StaggerOrder S; S.init2(MREAL, D_, FF_, F.G, (int)blockIdx.x, STAGGER ? (int)((blockIdx.x >> 3) & 3) : 0, WGM_RES);
            pg8::EpiResid E{WSP(bf16, WS_HB), SSQ(3), rp ? 0.f : 0.5f, F.lds + XR_OFF, nullptr, H16_MASTER ? WSP(bf16, WS_H16) : nullptr, (H16_MASTER && L == DEPTH - 1) ? 1 : 0}; pg8::gemm_phase<pg8::EpiResid, pg8::StaggerOrder, true, true>(F.lds + RING_OFF, g, S, E); }
        SEAM(pb + 7); }
    }
    { constexpr int Lc = 3;
        const int pb = 2 + 8 * Lc;
        _Pragma("unroll 1") for (int rp = 0; rp < NREP(2); ++rp) {
        if (EN(2) && IN(pb + 0)) { const KArgs A = kargs(); LAYER(); if (!rp) thin_gu<!H16_MASTER>(WSP(bf16, WS_HM), WL(WL_GU1), SSQM(0), WSP(bf16, WS_MIDM), THIN_ARGS); pg8::Gemm g{WSP(bf16, WS_HB), WL(WL_GU1), MREAL, 2 * FF_, D_, LDH, LDH}; pg8::StaticOrder S; S.init(MREAL, 2 * FF_, F.G, (int)blockIdx.x, WGM_GU);
#if PROBE_VAR >= 6
            if (rp) { pg8::EpiSwiGLUT<PROBE_VAR> E2{WSP(bf16, WS_MID), SSQ(0)}; pg8::gemm_phase<pg8::EpiSwiGLUT<PROBE_VAR>, pg8::StaticOrder, true, true, !H16_MASTER>(F.lds + RING_OFF, g, S, E2); } else
#elif PROBE_VAR == 1 || PROBE_VAR == 2
            if (rp) { pg8::ProbeOrder<PROBE_VAR == 2> S2; S2.init(MREAL, 2 * FF_, F.G, (int)blockIdx.x); pg8::EpiSink E2{WSP(float, WS_SSQ)}; pg8::gemm_phase<pg8::EpiSink, pg8::ProbeOrder<PROBE_VAR == 2>, true, true, !H16_MASTER>(F.lds + RING_OFF, g, S2, E2); } else
#endif
            { pg8::EpiSwiGLU E{WSP(bf16, WS_MID), SSQ(0)}; pg8::gemm_phase<pg8::EpiSwiGLU, pg8::StaticOrder, true, true, !H16_MASTER>(F.lds + RING_OFF, g, S, E); } }
        SEAM(pb + 0); }
        _Pragma("unroll 1") for (int rp = 0; rp < NREP(3); ++rp) {
        if (EN(3) && IN(pb + 1)) { const KArgs A = kargs(); LAYER(); if (!rp) thin_resid<22>(WSP(bf16, WS_MIDM), WL(WL_D1), FF_, WSP(bf16, WS_HM), H16_MASTER ? WSP(bf16, WS_HM16) : nullptr, SSQM(1), 0.5f, THIN_ARGS); pg8::Gemm g{WSP(bf16, WS_MID), WL(WL_D1), MREAL, D_, FF_, LDM, LDM}; pg8::StaggerOrder S; S.init2(MREAL, D_, FF_, F.G, (int)blockIdx.x, STAGGER ? (int)((blockIdx.x >> 3) & 3) : 0, WGM_RES);
#if PROBE_VAR >= 3 && PROBE_VAR <= 5
            if (rp) { pg8::EpiResidT<PROBE_VAR> E2{WSP(bf16, WS_HB), SSQ(1), 0.f, F.lds + XR_OFF, (bf16*)A->out, H16_MASTER ? WSP(bf16, WS_H16) : nullptr, 0}; pg8::gemm_phase<pg8::EpiResidT<PROBE_VAR>, pg8::StaggerOrder, true, true>(F.lds + RING_OFF, g, S, E2); } else
#elif PROBE_VAR
            if (rp) { pg8::ProbeOrder<PROBE_VAR == 2> S2; S2.init(MREAL, D_, F.G, (int)blockIdx.x); pg8::EpiSink E2{WSP(float, WS_SSQ)}; pg8::gemm_phase<pg8::EpiSink, pg8::ProbeOrder<PROBE_VAR == 2>, true, true>(F.lds + RING_OFF, g, S2, E2); } else
#endif
            { pg8::EpiResid E{WSP(bf16, WS_HB), SSQ(1), rp ? 0.f : 0.5f, F.lds + XR_OFF, nullptr, H16_MASTER ? WSP(bf16, WS_H16) : nullptr, 0}; pg8::gemm_phase<pg8::EpiResid, pg8::StaggerOrder, true, true>(F.lds + RING_OFF, g, S, E); } }
        SEAM(pb + 1); }
        _Pragma("unroll 1") for (int rp = 0; rp < NREP(4); ++rp) {
        if (EN(4) && IN(pb + 2)) { const KArgs A = kargs(); LAYER(); if (!rp) thin_proj<!H16_MASTER>(WSP(bf16, WS_HM), WL(WL_IN), SSQM(1), WSP(bf16, WS_PROJ), WSP(float, WS_ROPE), WSP(float, WS_ROPE) + NPOS * 32, THIN_ARGS); pg8::Gemm g{WSP(bf16, WS_HB), WL(WL_IN), MREAL, INW, D_, LDH, LDH}; pg8::StaticOrder S; S.init(MREAL, INW, F.G, (int)blockIdx.x, WGM_IN);
            pg8::EpiProj E{WSP(bf16, WS_PROJ), SSQ(1), WSP(float, WS_ROPE), WSP(float, WS_ROPE) + NPOS * 32}; pg8::gemm_phase<pg8::EpiProj, pg8::StaticOrder, true, true, !H16_MASTER>(F.lds + RING_OFF, g, S, E); }
        SEAM(pb + 2); }
        _Pragma("unroll 1") for (int rp = 0; rp < NREP(5); ++rp) {
        if (EN(5) && IN(pb + 3)) { const KArgs A = kargs(); LAYER(); const bf16* PROJ = WSP(bf16, WS_PROJ); bf16* CAT = WSP(bf16, WS_CAT);
            const int ln_ = LANE(); const float sa = wave_sum(A->in[8][L * 64 + ln_] * A->in[9][L * 64 + ln_]), sb = wave_sum(A->in[10][L * 64 + ln_] * A->in[11][L * 64 + ln_]);
            const float lam = expf(sa) - expf(sb) + A->lam_init[L];
            for (int v = F.vcu; v < 256; v += F.G) { const int bh = v >> 1, sx = v & 1, b = bh >> 3, h = bh & 7;
#pragma unroll 1
                for (int i = 0; i < 8; ++i) { const int m = i & 1, qs = i >> 1;
                    const int qb = sx == 0 ? (qs == 0 ? 0 : qs == 1 ? 7 : qs == 2 ? 1 : 6) : (qs == 0 ? 2 : qs == 1 ? 5 : qs == 2 ? 3 : 4);
                    const attn_body::bf16* P = (const attn_body::bf16*)PROJ + (size_t)b * VSEQ * LDP;
                    attn_body::attn_unit<8>(qb, P + (size_t)(64 + 256 * qb) * LDP + (2 * h + m) * 64, P + 1024 + (2 * h + m) * 64, P + 2048 + h * 128,
                                            (attn_body::bf16*)CAT + (size_t)(b * NSEQ + 256 * qb) * LDH + h * 128, (char*)lds + RING_OFF, m, lam, (float*)(A->ws + WS_OSCR) + (size_t)v * 32768); } }
            { bf16* CATM = WSP(bf16, WS_CATM); const int lane = LANE();
              if (gw < NHEADS && NGW > 64) cb_meta_attn(PROJ, CATM, lam, gw, lane);
              else { const int w0 = NGW > 64 ? gw - NHEADS : gw, nw = NGW > 64 ? NGW - NHEADS : NGW;
                if (NGW <= 64) for (int it = gw; it < NHEADS; it += NGW) cb_meta_attn(PROJ, CATM, lam, it, lane);
                for (int it = w0; it < NMETA + NBATCH * 128; it += nw) {
                    if (it < NMETA) cb_row((const bf16*)nullptr, PROJ, CAT, CATM, lam, MREAL + it, lane);
                    else cb_pool_item(PROJ, CAT, it - NMETA, lane); } } }
        }
        SEAM(pb + 3); }
        _Pragma("unroll 1") for (int rp = 0; rp < NREP(7); ++rp) {
        if (EN(7) && IN(pb + 5)) { const KArgs A = kargs(); LAYER(); if (!rp) thin_resid<8>(WSP(bf16, WS_CATM), WL(WL_OUT), D_, WSP(bf16, WS_HM), H16_MASTER ? WSP(bf16, WS_HM16) : nullptr, SSQM(2), 1.0f, THIN_ARGS); pg8::Gemm g{WSP(bf16, WS_CAT), WL(WL_OUT), MREAL, D_, D_, LDH, LDH}; pg8::StaggerOrder S; S.init2(MREAL, D_, D_, F.G, (int)blockIdx.x, STAGGER ? (int)((blockIdx.x >> 3) & 3) : 0, WGM_RES);
            pg8::EpiResid E{WSP(bf16, WS_HB), SSQ(2), rp ? 0.f : 1.0f, F.lds + XR_OFF, nullptr, H16_MASTER ? WSP(bf16, WS_H16) : nullptr, 0}; pg8::gemm_phase<pg8::EpiResid, pg8::StaggerOrder, true, true>(F.lds + RING_OFF, g, S, E); }
        SEAM(pb + 5); }
        _Pragma("unroll 1") for (int rp = 0; rp < NREP(8); ++rp) {
        if (EN(8) && IN(pb + 6)) { const KArgs A = kargs(); LAYER(); if (!rp) thin_gu<!H16_MASTER>(WSP(bf16, WS_HM), WL(WL_GU2), SSQM(2), WSP(bf16, WS_MIDM), THIN_ARGS); pg8::Gemm g{WSP(bf16, WS_HB), WL(WL_GU2), MREAL, 2 * FF_, D_, LDH, LDH}; pg8::StaticOrder S; S.init(MREAL, 2 * FF_, F.G, (int)blockIdx.x, WGM_GU);
            pg8::EpiSwiGLU E{WSP(bf16, WS_MID), SSQ(2)}; pg8::gemm_phase<pg8::EpiSwiGLU, pg8::StaticOrder, true, true, !H16_MASTER>(F.lds + RING_OFF, g, S, E); }
        SEAM(pb + 6); }
        _Pragma("unroll 1") for (int rp = 0; rp < NREP(9); ++rp) {
        if (EN(9) && IN(pb + 7)) { const KArgs A = kargs(); LAYER(); if (!rp) thin_resid<22>(WSP(bf16, WS_MIDM), WL(WL_D2), FF_, WSP(bf16, WS_HM), H16_MASTER ? WSP(bf16, WS_HM16) : nullptr, SSQM(3), 0.5f, THIN_ARGS); pg8::Gemm g{WSP(bf16, WS_MID), WL(WL_D2), MREAL, D_, FF_, LDM, LDM}; pg8::StaggerOrder S; S.init2(MREAL, D_, FF_, F.G, (int)blockIdx.x, STAGGER ? (int)((blockIdx.x >> 3) & 3) : 0, WGM_RES);
            pg8::EpiResid E{WSP(bf16, WS_HB), SSQ(3), rp ? 0.f : 0.5f, F.lds + XR_OFF, nullptr, H16_MASTER ? WSP(bf16, WS_H16) : nullptr, (H16_MASTER && L == DEPTH - 1) ? 1 : 0}; pg8::gemm_phase<pg8::EpiResid, pg8::StaggerOrder, true, true>(F.lds + RING_OFF, g, S, E); }
        SEAM(pb + 7); }
    }
    if (EN(10) && IN(NPHASE - 1)) { const KArgs A = kargs(); const int lane = LANE(); const bf16* HBp = H16_MASTER ? WSP(bf16, WS_H16) : WSP(bf16, WS_HB); float* outp = A->out;
        const float* ssq = (const float*)(A->ws + WS_SSQ + (size_t)12 * SSQ_SET); const float* gf = A->in[20];
        unsigned poison = 0u;
        if (hi - lo > 1) poison = __hip_atomic_load((gu32*)((gu32*)(A->ws + WS_CTL) + CW_BAR + XB_TMO), RLX_AGENT);
        for (int r = gw; r < MREAL; r += NGW) {
            float s = 0.f;
#pragma unroll
            for (int p = 0; p < 8; ++p) s += ssq[(size_t)p * MROWS + r];
            float rn = 1.0f / sqrtf(s * (1.0f / 2048.0f) + NORM_EPS); if (poison) rn = __builtin_nanf("");
            const unsigned long long* h8 = (const unsigned long long*)(HBp + (size_t)r * LDH) + lane; const f32x4* g4 = (const f32x4*)gf + lane; f32x4* o4 = (f32x4*)(outp + (size_t)r * D_) + lane;
#pragma unroll
            for (int j = 0; j < 8; ++j) { const unsigned long long w = h8[64 * j]; const unsigned w0 = (unsigned)w, w1 = (unsigned)(w >> 32);
                const f32x4 hv = (f32x4){pg8::f16_lo(w0), pg8::f16_hi(w0), pg8::f16_lo(w1), pg8::f16_hi(w1)}; o4[64 * j] = hv * rn * g4[64 * j]; }
#if PROBE
            { const unsigned long long* st = (const unsigned long long*)(A->ws + WS_STAMP); const float pa = (float)(st[PROBE_A1] - st[PROBE_A0]) * 0.01f, pbv = (float)(st[PROBE_B1] - st[PROBE_B0]) * 0.01f;
              if (r >= MREAL - 512) { for (int j = 0; j < 8; ++j) o4[64 * j] = (f32x4){pbv, pbv, pbv, pbv}; }
              if (r == 0 && lane == 0) { o4[0].x = pa; } }
#endif
        }
    }
#undef IN
#undef SEAM
#undef LAYER
#undef SSQM
#undef THIN_ARGS
#undef STAMP
#undef LANE
#undef WSP
#undef WL
#undef SSQ
}

extern "C" void kernel_launch(void* const* d_in, const int* in_sizes, int n_in, void* d_out, int out_size, void* d_ws, size_t ws_size, hipStream_t stream) {
    static int grid = 0;
    if (grid == 0) {
        if (n_in != 21 || in_sizes[0] != MREAL * D_ || out_size != MREAL * D_ || ws_size < WS_END) { fprintf(stderr, "kernel_launch: unexpected shapes (n_in %d, in0 %d, out %d, ws %zu < %zu); nothing launched\n", n_in, n_in > 0 ? in_sizes[0] : -1, out_size, ws_size, (size_t)WS_END); grid = -1; return; }
        int dev = 0, cus = 0, per_cu = 0;
        if (hipGetDevice(&dev) != hipSuccess || hipDeviceGetAttribute(&cus, hipDeviceAttributeMultiprocessorCount, dev) != hipSuccess) { grid = -1; return; }
        if (hipFuncSetAttribute((const void*)fwd_kernel, hipFuncAttributeMaxDynamicSharedMemorySize, LDS_BYTES) != hipSuccess) { fprintf(stderr, "kernel_launch: hipFuncSetAttribute failed\n"); grid = -1; return; }
        if (hipOccupancyMaxActiveBlocksPerMultiprocessor(&per_cu, (const void*)fwd_kernel, NWAVES * 64, LDS_BYTES) != hipSuccess || per_cu < 1) { fprintf(stderr, "kernel_launch: occupancy query reports %d workgroups per CU\n", per_cu); }
        (void)hipGetLastError();
        grid = cus;
    }
    if (grid < 0) return;
    if (hipMemsetAsync((char*)d_ws + WS_CTL, 0, CTL_ZERO_BYTES, stream) != hipSuccess) { fprintf(stderr, "kernel_launch: memset failed\n"); return; }
    Args a{};
    for (int i = 0; i < 21; ++i) a.in[i] = (const float*)d_in[i];
    a.out = (float*)d_out; a.ws = (unsigned char*)d_ws;
    for (int L = 0; L < 4; ++L) a.lam_init[L] = (float)(0.8 - 0.6 * exp(-0.3 * (double)L));
#if MK_ONE_LAUNCH
    a.ph_lo = 0; a.ph_hi = NPHASE;
    hipLaunchKernelGGL(fwd_kernel, dim3(grid), dim3(NWAVES * 64), LDS_BYTES, stream, a);
#else
    for (int p = 0; p < NPHASE; ++p) { a.ph_lo = p; a.ph_hi = p + 1; hipLaunchKernelGGL(fwd_kernel, dim3(grid), dim3(NWAVES * 64), LDS_BYTES, stream, a); }
#endif
    const hipError_t le = hipPeekAtLastError();
    if (le != hipSuccess) fprintf(stderr, "kernel_launch: launch failed: %s\n", hipGetErrorName(le));
}
```
